# Optimizing an MI355X kernel written in HIP

```python
import math
import jax, jax.numpy as jnp
from jax import lax
import numpy as np

D_MODEL = 1024
BATCH = 8
SEQ = 2048
DEPTH = 1

A_WIDTH = D_MODEL // 2
A_GROUPS = 8
A_GROUP_DIM = A_WIDTH // A_GROUPS
CHUNK = 128
B_WIDTH = D_MODEL // 2
HYENA_ORDER = 2
SHORT_CONV = 3
FILTER_EMB = 33
FILTER_HIDDEN = 64
N_DIRS = 2
DECAY_TARGET = 1e-2
FAST_DECAY_PCT = 0.3
SLOW_DECAY_PCT = 1.5
DECAY_SHIFT = 0.05
N_BRANCHES = 2
D_FF = 4 * D_MODEL
EPS = 1e-6
IN_COLS = 2 * A_WIDTH + (HYENA_ORDER + 1) * B_WIDTH + N_BRANCHES * D_MODEL

kernel_name = "hybrid_gmlp_hyena_encoder_block"


def rmsnorm(x, g):
    xf = x.astype(jnp.float32)
    r = xf * lax.rsqrt(jnp.mean(xf * xf, axis=-1, keepdims=True) + EPS)
    return (r * g.astype(jnp.float32)).astype(x.dtype)


def layernorm(x, g):
    xf = x.astype(jnp.float32)
    mu = jnp.mean(xf, axis=-1, keepdims=True)
    var = jnp.mean(jnp.square(xf - mu), axis=-1, keepdims=True)
    return ((xf - mu) * lax.rsqrt(var + EPS) * g.astype(jnp.float32)).astype(x.dtype)


def spatial_gating(z, v_gain, w_s, b_s):
    u, v = jnp.split(z, 2, axis=-1)
    v = layernorm(v, v_gain)
    bsz, L, _ = v.shape
    vc = v.reshape(bsz, L // CHUNK, CHUNK, A_GROUPS, A_GROUP_DIM)
    s = jnp.einsum('gts,bcsgd->bctgd', w_s, vc) + b_s.T[None, None, :, :, None]
    return u * s.reshape(bsz, L, A_WIDTH)


def short_conv(z, w, b):
    L = z.shape[1]
    half = SHORT_CONV // 2
    zp = jnp.pad(z, ((0, 0), (half, half), (0, 0)))
    return sum(zp[:, k:k + L] * w[k] for k in range(SHORT_CONV)) + b


def hyena_filters(L, w1, b1, f1, w2, b2, f2, w3):
    f32 = jnp.float32
    t = jnp.linspace(0.0, 1.0, L, dtype=f32)[:, None]
    bands = (FILTER_EMB - 1) // 2
    w = 2.0 * math.pi * jnp.arange(L, dtype=f32)[:, None] / L
    fr = jnp.linspace(1e-4, bands - 1, bands, dtype=f32)[None, :]
    feats = jnp.concatenate([t, jnp.cos(fr * w), -jnp.sin(fr * w)], axis=-1)
    h = jnp.sin(f1.astype(f32) * (feats @ w1.astype(f32) + b1.astype(f32)))
    h = jnp.sin(f2.astype(f32) * (h @ w2.astype(f32) + b2.astype(f32)))
    h = (h @ w3.astype(f32)).reshape(L, HYENA_ORDER, N_DIRS, B_WIDTH)
    max_decay = math.log(DECAY_TARGET) / FAST_DECAY_PCT
    min_decay = math.log(DECAY_TARGET) / SLOW_DECAY_PCT
    deltas = jnp.abs(jnp.linspace(min_decay, max_decay, B_WIDTH, dtype=f32))
    decay = jnp.exp(-t[:, :, None, None] * deltas)
    h = h * (decay + DECAY_SHIFT)
    return h * lax.rsqrt(jnp.sum(h * h, axis=(0, 2), keepdims=True) + EPS)


def bidir_fft_conv(z, h_fwd, h_bwd, skip):
    L, C = h_fwd.shape
    k = jnp.concatenate([h_fwd.at[0].add(h_bwd[0]),
                         jnp.zeros((1, C), jnp.float32),
                         h_bwd[:0:-1]], axis=0)
    kf = jnp.fft.rfft(k, axis=0)
    zf32 = z.astype(jnp.float32)
    zf = jnp.fft.rfft(zf32, n=2 * L, axis=1)
    y = jnp.fft.irfft(zf * kf[None], n=2 * L, axis=1)[:, :L]
    return (y + zf32 * skip.astype(jnp.float32)).astype(z.dtype)


def hyena_mixer(p, conv_w, conv_b, w1, b1, f1, w2, b2, f2, w3, skip):
    L = p.shape[1]
    pc = short_conv(p, conv_w, conv_b)
    x1, x2, v = jnp.split(pc, HYENA_ORDER + 1, axis=-1)
    filt = hyena_filters(L, w1, b1, f1, w2, b2, f2, w3)
    z = v
    z = x1 * bidir_fft_conv(z, filt[:, 0, 0], filt[:, 0, 1], skip[0])
    z = x2 * bidir_fft_conv(z, filt[:, 1, 0], filt[:, 1, 1], skip[1])
    return z


def setup_inputs(seed: int = 0) -> dict:
    key = jax.random.key(seed)
    ks = jax.random.split(key, 32)
    nrm = lambda k, s, sc: jax.random.normal(k, s, jnp.float32) * sc
    gain = lambda k, s: 1.0 + 0.02 * jax.random.normal(k, s, jnp.float32)
    Dp = DEPTH
    return {
        "x": nrm(ks[0], (BATCH, SEQ, D_MODEL), 1.0),
        "g_pre_mix": gain(ks[1], (Dp, D_MODEL)),
        "w_in": nrm(ks[2], (Dp, D_MODEL, IN_COLS), D_MODEL ** -0.5),
        "a_v_gain": gain(ks[3], (Dp, A_WIDTH)),
        "a_w_s": nrm(ks[4], (Dp, A_GROUPS, CHUNK, CHUNK), CHUNK ** -0.5),
        "a_b_s": gain(ks[5], (Dp, A_GROUPS, CHUNK)),
        "w_out_a": nrm(ks[6], (Dp, A_WIDTH, D_MODEL), A_WIDTH ** -0.5),
        "b_conv_w": nrm(ks[7], (Dp, SHORT_CONV, (HYENA_ORDER + 1) * B_WIDTH), SHORT_CONV ** -0.5),
        "b_conv_b": nrm(ks[8], (Dp, (HYENA_ORDER + 1) * B_WIDTH), 0.02),
        "b_filt_w1": nrm(ks[9], (Dp, FILTER_EMB, FILTER_HIDDEN), FILTER_EMB ** -0.5),
        "b_filt_b1": nrm(ks[10], (Dp, FILTER_HIDDEN), 0.02),
        "b_filt_f1": gain(ks[11], (Dp, FILTER_HIDDEN)),
        "b_filt_w2": nrm(ks[12], (Dp, FILTER_HIDDEN, FILTER_HIDDEN), FILTER_HIDDEN ** -0.5),
        "b_filt_b2": nrm(ks[13], (Dp, FILTER_HIDDEN), 0.02),
        "b_filt_f2": gain(ks[14], (Dp, FILTER_HIDDEN)),
        "b_filt_w3": nrm(ks[15], (Dp, FILTER_HIDDEN, HYENA_ORDER * N_DIRS * B_WIDTH), FILTER_HIDDEN ** -0.5),
        "b_skip": nrm(ks[16], (Dp, HYENA_ORDER, B_WIDTH), 1.0),
        "w_out_b": nrm(ks[17], (Dp, B_WIDTH, D_MODEL), B_WIDTH ** -0.5),
        "w_o": nrm(ks[18], (Dp, D_MODEL, D_MODEL), D_MODEL ** -0.5),
        "g_post_mix": gain(ks[19], (Dp, D_MODEL)),
        "g_pre_ffn": gain(ks[20], (Dp, D_MODEL)),
        "w_ff1": nrm(ks[21], (Dp, D_MODEL, D_FF), D_MODEL ** -0.5),
        "w_ff2": nrm(ks[22], (Dp, D_FF, D_MODEL), D_FF ** -0.5),
        "g_post_ffn": gain(ks[23], (Dp, D_MODEL)),
    }


def reference(x, g_pre_mix, w_in, a_v_gain, a_w_s, a_b_s, w_out_a, b_conv_w, b_conv_b,
              b_filt_w1, b_filt_b1, b_filt_f1, b_filt_w2, b_filt_b2, b_filt_f2, b_filt_w3,
              b_skip, w_out_b, w_o, g_post_mix, g_pre_ffn, w_ff1, w_ff2, g_post_ffn):
    h = x
    split_a = 2 * A_WIDTH
    split_b = split_a + (HYENA_ORDER + 1) * B_WIDTH
    for i in range(DEPTH):
        xn = rmsnorm(h, g_pre_mix[i])
        p = jnp.einsum('bld,dc->blc', xn, w_in[i])
        p_a, p_b, p_g = p[..., :split_a], p[..., split_a:split_b], p[..., split_b:]
        y_a = spatial_gating(jax.nn.gelu(p_a), a_v_gain[i], a_w_s[i], a_b_s[i])
        y_a = jnp.einsum('blc,cd->bld', y_a, w_out_a[i])
        y_b = hyena_mixer(p_b, b_conv_w[i], b_conv_b[i], b_filt_w1[i], b_filt_b1[i],
                          b_filt_f1[i], b_filt_w2[i], b_filt_b2[i], b_filt_f2[i],
                          b_filt_w3[i], b_skip[i])
        y_b = jnp.einsum('blc,cd->bld', y_b, w_out_b[i])
        g_a, g_b = jnp.split(jax.nn.sigmoid(p_g), N_BRANCHES, axis=-1)
        m = jnp.einsum('bld,de->ble', g_a * y_a + g_b * y_b, w_o[i])
        h = h + rmsnorm(m, g_post_mix[i])
        hn = rmsnorm(h, g_pre_ffn[i])
        f = jnp.square(jax.nn.relu(jnp.einsum('bld,df->blf', hn, w_ff1[i])))
        f = jnp.einsum('blf,fd->bld', f, w_ff2[i])
        h = h + rmsnorm(f, g_post_ffn[i])
    return h
```

```cpp
#include <hip/hip_runtime.h>
#include <hip/hip_cooperative_groups.h>
#include <cstdio>
#include <cstdint>
namespace cg = cooperative_groups;
namespace pg8 {
#define PG8_LAS __attribute__((address_space(3)))
typedef unsigned short bf16_t;
typedef short bf16x8 __attribute__((ext_vector_type(8)));
typedef float f32x4 __attribute__((ext_vector_type(4)));
typedef unsigned u32x4 __attribute__((ext_vector_type(4)));
constexpr int BM = 256, BK = 64, HALF = 128, HTB = HALF * BK * 2  , STAGE_BYTES = 8 * HTB, NXCD = 8, WGM = 8;

__host__ __device__ __forceinline__ int lds_byte(int r, int c) { const int st = (r >> 4) * 2 + (c >> 5), rr = r & 15, cc = c & 31, ob = rr * 64 + cc * 2; return st * 1024 + (ob ^ (((ob >> 9) & 1) << 5)); }
__host__ __device__ __forceinline__ void stage_rc(int b, int& R, int& C) { const int st = b / 1024, sb = b % 1024, swz = sb ^ (((sb >> 9) & 1) << 5); R = (st >> 1) * 16 + swz / 64; C = (st & 1) * 32 + (swz % 64) / 2; }
__host__ __device__ __forceinline__ int perm32(int rho) { const int n = rho >> 4, i = rho & 15; return 8 * (i >> 2) + 4 * n + (i & 3); }
__device__ __forceinline__ unsigned cvt_pk_bf16(float lo, float hi) { unsigned r; asm volatile("v_cvt_pk_bf16_f32 %0, %1, %2" : "=v"(r) : "v"(lo), "v"(hi)); return r; }
typedef float f32x2 __attribute__((ext_vector_type(2)));

struct Unit { int pm, pn, sel; };
struct Gemm { const bf16_t* A; const bf16_t* Bt; const bf16_t* A2; const bf16_t* Bt2; int M, N, K; };
template <int CH> struct OrderT {
    int nM, nN, nwg, G, c;
    __host__ __device__ void init(int M, int N, int G_, int c_) { nM = M / BM; nN = N / BM; nwg = nM * nN; G = G_; c = c_; }
    __host__ __device__ bool next(int i, Unit& u) const {
        const long L = (long)(i / CH) * G + c; if (L >= nwg) return false;
        int wgid = (int)L; { const int q = nwg / NXCD, r = nwg % NXCD, xcd = wgid % NXCD, off = wgid / NXCD; wgid = (xcd < r ? xcd * (q + 1) : r * (q + 1) + (xcd - r) * q) + off; }
        const int nig = WGM * nN, gid = wgid / nig, fm = gid * WGM, gsz = (nM - fm) < WGM ? (nM - fm) : WGM;
        u.pm = fm + ((wgid % nig) % gsz); u.pn = (wgid % nig) / gsz; u.sel = i % CH; return true;
    }
    __device__ __forceinline__ void a_ready(const Unit&) const {}
    __device__ __forceinline__ void done(const Unit&) const {}
};
typedef OrderT<1> StaticOrder;
typedef OrderT<2> ChainOrder;

template <class Epi, class Sched, bool ALIGN_EPI = false, bool SP2 = false>
__device__ __forceinline__ void gemm_phase(PG8_LAS unsigned char* lds, const Gemm g, const Sched& S, const Epi& E) {
    const int tid = threadIdx.x, wid = __builtin_amdgcn_readfirstlane(tid >> 6), lane = tid & 63, wr = wid >> 2, wc = wid & 3, fr = lane & 15, fq = lane >> 4;
    const int K = g.K, nt = K / BK;
    unsigned voffA[2], voffB[2];
#pragma unroll
    for (int i = 0; i < 2; ++i) { int R, C; stage_rc(tid * 16 + i * 8192, R, C); const int Rb = Epi::PERM ? ((R & ~31) + perm32(R & 31)) : R;
        voffA[i] = (unsigned)(R * K + C) * 2u; voffB[i] = (unsigned)(Rb * K + C) * 2u; }
    const size_t kstep = (size_t)(BK * 2);
    const size_t hstep = (size_t)HALF * K * 2;
    const size_t tstep = 2 * hstep;
    const unsigned ldsw = (unsigned)wid * 1024u;
    const int aoff = lds_byte(wr * 64 + fr, fq * 8), boff = lds_byte(wc * 32 + fr, fq * 8);
#define PG8_SA(b, h) (((b) * 2 + (h)) * HTB)
#define PG8_SB(b, h) ((4 + (b) * 2 + (h)) * HTB)
#define PG8_STAGE(bufoff, gbase, voff) do { _Pragma("unroll") for (int _i = 0; _i < 2; ++_i) \
        __builtin_amdgcn_global_load_lds((const unsigned*)((const char*)(gbase) + (voff)[_i]), (PG8_LAS unsigned*)(lds + (bufoff) + ldsw + _i * 8192), 16, 0, 0); } while (0)
#define PG8_LDA(dst, b, h) do { _Pragma("unroll") for (int m = 0; m < 4; ++m) _Pragma("unroll") for (int k = 0; k < 2; ++k) dst[m][k] = *(const PG8_LAS bf16x8*)(lds + PG8_SA(b, h) + aoff + m * 2048 + k * 1024); } while (0)
#define PG8_LDB(dst, b, h) do { _Pragma("unroll") for (int n = 0; n < 2; ++n) _Pragma("unroll") for (int k = 0; k < 2; ++k) dst[n][k] = *(const PG8_LAS bf16x8*)(lds + PG8_SB(b, h) + boff + n * 2048 + k * 1024); } while (0)
#define PG8_MMA(ai, bj, At, Bt) do { __builtin_amdgcn_s_setprio(1); _Pragma("unroll") for (int m = 0; m < 4; ++m) _Pragma("unroll") for (int n = 0; n < 2; ++n) _Pragma("unroll") for (int k = 0; k < 2; ++k) \
        acc[ai][bj][m][n] = __builtin_amdgcn_mfma_f32_16x16x32_bf16(Bt[n][k], At[m][k], acc[ai][bj][m][n], 0, 0, 0); __builtin_amdgcn_s_setprio(0); } while (0)
#define PG8_WAIT_V(n) asm volatile("s_waitcnt vmcnt(" #n ")" ::: "memory")
#define PG8_WAIT_L(n) asm volatile("s_waitcnt lgkmcnt(" #n ")" ::: "memory")
#define PG8_BAR __builtin_amdgcn_s_barrier()
#define PG8_SCHED __builtin_amdgcn_sched_barrier(0)
    Unit cur, nxt; int ui = 0;
    if (!S.next(0, cur)) return;
    f32x4 acc[2][2][4][2];
#pragma unroll
    for (int a = 0; a < 2; ++a)
#pragma unroll
        for (int b = 0; b < 2; ++b)
#pragma unroll
            for (int m = 0; m < 4; ++m)
#pragma unroll
                for (int n = 0; n < 2; ++n) acc[a][b][m][n] = (f32x4){0.f, 0.f, 0.f, 0.f};
    bf16x8 At[4][2], B0[2][2], B1[2][2];
    const char* cA = (const char*)(cur.sel ? g.A2 : g.A) + (size_t)cur.pm * tstep; const char* cB = (const char*)(cur.sel ? g.Bt2 : g.Bt) + (size_t)cur.pn * tstep;
    S.a_ready(cur);
    if constexpr (SP2) {
        PG8_STAGE(PG8_SB(0, 0), cB, voffB); PG8_STAGE(PG8_SB(0, 1), cB + hstep, voffB); PG8_STAGE(PG8_SA(0, 0), cA, voffA); PG8_STAGE(PG8_SA(0, 1), cA + hstep, voffA);
        if (wr == 1) PG8_BAR;
        PG8_WAIT_V(2); PG8_BAR;
        PG8_STAGE(PG8_SB(1, 0), cB + kstep, voffB); PG8_STAGE(PG8_SA(1, 0), cA + kstep, voffA); PG8_STAGE(PG8_SB(1, 1), cB + hstep + kstep, voffB);
        PG8_WAIT_V(6); PG8_BAR;
    } else {
        PG8_STAGE(PG8_SB(0, 0), cB, voffB); PG8_STAGE(PG8_SA(0, 0), cA, voffA); PG8_STAGE(PG8_SB(0, 1), cB + hstep, voffB); PG8_STAGE(PG8_SA(0, 1), cA + hstep, voffA);
        if (wr == 1) PG8_BAR;
        PG8_WAIT_V(4); PG8_BAR;
        PG8_STAGE(PG8_SB(1, 0), cB + kstep, voffB); PG8_STAGE(PG8_SA(1, 0), cA + kstep, voffA); PG8_STAGE(PG8_SB(1, 1), cB + hstep + kstep, voffB);
        PG8_WAIT_V(6); PG8_BAR;
    }
    for (;;) {
        const bool has_next = S.next(ui + 1, nxt);
        const char* nA = has_next ? (const char*)(nxt.sel ? g.A2 : g.A) + (size_t)nxt.pm * tstep : cA; const char* nB = has_next ? (const char*)(nxt.sel ? g.Bt2 : g.Bt) + (size_t)nxt.pn * tstep : cB;
        for (int t = 0; t < nt; t += 2) {
            const bool last = (t == nt - 2);
            const char* a1 = cA + (size_t)(t + 1) * kstep;
            const char* a2 = last ? nA : cA + (size_t)(t + 2) * kstep; const char* b2 = last ? nB : cB + (size_t)(t + 2) * kstep;
            const char* a3 = a2 + kstep; const char* b3 = b2 + kstep;
            if (last && has_next) S.a_ready(nxt);
            if constexpr (SP2) {
            PG8_LDB(B0, 0, 0); PG8_LDB(B1, 0, 1); PG8_SCHED; PG8_LDA(At, 0, 0); PG8_STAGE(PG8_SA(1, 1), a1 + hstep, voffA);
            PG8_WAIT_V(8); PG8_WAIT_L(0); PG8_BAR; PG8_MMA(0, 0, At, B0); PG8_MMA(0, 1, At, B1); PG8_BAR; PG8_SCHED;
            PG8_LDA(At, 0, 1); PG8_STAGE(PG8_SB(0, 0), b2, voffB); PG8_STAGE(PG8_SB(0, 1), b2 + hstep, voffB); PG8_STAGE(PG8_SA(0, 0), a2, voffA);
            PG8_WAIT_V(8); PG8_WAIT_L(0); PG8_BAR; PG8_MMA(1, 0, At, B0); PG8_MMA(1, 1, At, B1); PG8_BAR; PG8_SCHED;
            PG8_LDB(B0, 1, 0); PG8_LDB(B1, 1, 1); PG8_SCHED; PG8_LDA(At, 1, 0); PG8_STAGE(PG8_SA(0, 1), a2 + hstep, voffA);
            PG8_WAIT_V(8); PG8_WAIT_L(0); PG8_BAR; PG8_MMA(0, 0, At, B0); PG8_MMA(0, 1, At, B1); PG8_BAR; PG8_SCHED;
            PG8_LDA(At, 1, 1); PG8_STAGE(PG8_SB(1, 0), b3, voffB); PG8_STAGE(PG8_SB(1, 1), b3 + hstep, voffB); PG8_STAGE(PG8_SA(1, 0), a3, voffA);
            PG8_WAIT_V(8); PG8_WAIT_L(0); PG8_BAR; PG8_MMA(1, 0, At, B0); PG8_MMA(1, 1, At, B1); PG8_BAR; PG8_SCHED;
            } else {
            PG8_LDB(B0, 0, 0); PG8_SCHED; PG8_LDA(At, 0, 0); PG8_STAGE(PG8_SA(1, 1), a1 + hstep, voffA);
            PG8_WAIT_L(8); PG8_BAR; PG8_WAIT_L(0); PG8_MMA(0, 0, At, B0); PG8_BAR; PG8_SCHED;
            PG8_LDB(B1, 0, 1); PG8_STAGE(PG8_SB(0, 0), b2, voffB);
            PG8_BAR; PG8_WAIT_L(0); PG8_MMA(0, 1, At, B1); PG8_BAR;
            PG8_LDA(At, 0, 1); PG8_STAGE(PG8_SA(0, 0), a2, voffA);
            PG8_BAR; PG8_WAIT_L(0); PG8_MMA(1, 0, At, B0); PG8_BAR; PG8_SCHED;
            PG8_STAGE(PG8_SB(0, 1), b2 + hstep, voffB);
            PG8_WAIT_V(6); PG8_BAR; PG8_MMA(1, 1, At, B1); PG8_BAR;
            PG8_LDB(B0, 1, 0); PG8_SCHED; PG8_LDA(At, 1, 0); PG8_STAGE(PG8_SA(0, 1), a2 + hstep, voffA);
            PG8_WAIT_L(8); PG8_BAR; PG8_WAIT_L(0); PG8_MMA(0, 0, At, B0); PG8_BAR; PG8_SCHED;
            PG8_LDB(B1, 1, 1); PG8_STAGE(PG8_SB(1, 0), b3, voffB);
            PG8_BAR; PG8_WAIT_L(0); PG8_MMA(0, 1, At, B1); PG8_BAR;
            PG8_LDA(At, 1, 1); PG8_STAGE(PG8_SA(1, 0), a3, voffA);
            PG8_BAR; PG8_WAIT_L(0); PG8_MMA(1, 0, At, B0); PG8_BAR; PG8_SCHED;
            PG8_STAGE(PG8_SB(1, 1), b3 + hstep, voffB);
            PG8_WAIT_V(6); PG8_BAR; PG8_MMA(1, 1, At, B1); PG8_BAR;
            }
        }
        if constexpr (ALIGN_EPI) { if (wr == 0) PG8_BAR; }
        bool keep = false;
        if constexpr (Epi::CHAIN) { keep = (cur.sel == 0); if (keep) E.mid(acc, cur, wr, wc, fr, fq); else E(acc, cur, wr, wc, fr, fq); }
        else if constexpr (!Epi::AFTER_DRAIN) { E(acc, cur, wr, wc, fr, fq); S.done(cur); }
        if (!has_next) break;
        if (!keep) {
#pragma unroll
        for (int a = 0; a < 2; ++a)
#pragma unroll
            for (int b = 0; b < 2; ++b)
#pragma unroll
                for (int m = 0; m < 4; ++m)
#pragma unroll
                    for (int n = 0; n < 2; ++n) acc[a][b][m][n] = (f32x4){0.f, 0.f, 0.f, 0.f};
        }
        cur = nxt; cA = nA; cB = nB; ++ui;
        if constexpr (ALIGN_EPI) { if (wr == 1) PG8_BAR; }
    }
    PG8_WAIT_V(0);
    if constexpr (!ALIGN_EPI) { if (wr == 0) PG8_BAR; }
    PG8_BAR;
    if constexpr (Epi::AFTER_DRAIN) { E.fused(acc, cur, wr, wc, fr, fq, lds, wid, lane); S.done(cur); }
#undef PG8_SA
#undef PG8_SB
#undef PG8_STAGE
#undef PG8_LDA
#undef PG8_LDB
#undef PG8_MMA
#undef PG8_WAIT_V
#undef PG8_WAIT_L
#undef PG8_BAR
#undef PG8_SCHED
}
}

#define LAS __attribute__((address_space(3)))
typedef unsigned short bf16;
typedef unsigned v4u __attribute__((ext_vector_type(4)));
typedef unsigned v2u __attribute__((ext_vector_type(2)));
typedef float f32x4 __attribute__((ext_vector_type(4)));
typedef short bf16x8 __attribute__((ext_vector_type(8)));

constexpr int NB = 8, SEQ = 2048, D = 1024, T = NB * SEQ;
constexpr int AW = 512, NG = 8, GD = 64, CHUNK = 128;
constexpr int BW = 512, FF = 4096;
constexpr int INC = 4608;
constexpr int FH = 64, FE = 33;
constexpr float EPS = 1e-6f;
constexpr int NWAVES = 8, NTHR = 512;
constexpr int LDS_BYTES = 147456;

constexpr size_t MiB = 1u << 20;
constexpr size_t WS_CTL = 0;
constexpr size_t WS_H2 = 1 * MiB;
constexpr size_t WS_SSP = WS_H2 + 512 * 1024;
constexpr size_t WS_WSB = WS_SSP + 256 * 1024;
constexpr size_t WS_WAG = 2 * MiB;
constexpr size_t WS_WPB = 8 * MiB;
constexpr size_t WS_WA = 12 * MiB, WS_WB = 13 * MiB, WS_WO = 14 * MiB, WS_W1 = 16 * MiB, WS_W2 = 24 * MiB;
constexpr size_t WS_XN = 32 * MiB;
constexpr size_t WS_ZA = 64 * MiB;
constexpr size_t WS_YBT = 64 * MiB;
constexpr size_t WS_MIX = 64 * MiB;
constexpr size_t WS_F1 = 64 * MiB;
constexpr size_t WS_PBT = 96 * MiB;
constexpr size_t WS_GATES = 144 * MiB;
constexpr size_t WS_YA = 208 * MiB;
constexpr size_t WS_YB = 224 * MiB;
constexpr size_t WS_Z1T = 240 * MiB;
constexpr size_t WS_F = 192 * MiB;
constexpr size_t WS_END = 256 * MiB;

__device__ __forceinline__ unsigned f2bf(float f) { unsigned u = __builtin_bit_cast(unsigned, f); return (u + 0x7fffu + ((u >> 16) & 1u)) >> 16; }
__device__ __forceinline__ unsigned pk2(float lo, float hi) { return f2bf(lo) | (f2bf(hi) << 16); }
__device__ __forceinline__ float bf2f(unsigned short b) { return __builtin_bit_cast(float, (unsigned)b << 16); }
__device__ __forceinline__ float bflo(unsigned w) { return __builtin_bit_cast(float, w << 16); }
__device__ __forceinline__ float bfhi(unsigned w) { return __builtin_bit_cast(float, w & 0xffff0000u); }
__device__ __forceinline__ float wave_sum(float v) {
#pragma unroll
    for (int o = 1; o < 64; o <<= 1) v += __shfl_xor(v, o);
    return v;
}
#define LDS_WAIT() asm volatile("s_waitcnt lgkmcnt(0)" ::: "memory")

namespace pg8 {
struct EpiInA {
    static constexpr bool PERM = true, AFTER_DRAIN = false, CHAIN = false;
    bf16_t* ZA; bf16_t* GT;
    __device__ __forceinline__ void operator()(const f32x4 (&acc)[2][2][4][2], const Unit& u, int wr, int wc, int fr, int fq) const {
        const int row0 = u.pm * BM + wr * 64 + fr; const bool isg = u.pn >= 4;
        bf16_t* base = isg ? GT : ZA; const int ldc = isg ? 2048 : 1024; const int col0 = (isg ? (u.pn - 4) : u.pn) * BM + wc * 32 + 8 * fq;
#pragma unroll
        for (int ai = 0; ai < 2; ++ai)
#pragma unroll
            for (int m = 0; m < 4; ++m) { bf16_t* rowp = base + (size_t)(row0 + ai * HALF + m * 16) * ldc + col0;
#pragma unroll
                for (int bj = 0; bj < 2; ++bj) { float v[8];
#pragma unroll
                    for (int j = 0; j < 4; ++j) { v[j] = acc[ai][bj][m][0][j]; v[4 + j] = acc[ai][bj][m][1][j]; }
#pragma unroll
                    for (int j = 0; j < 8; ++j) { const float x = v[j];
                        const float arg = isg ? x : 1.5957691216057308f * (x + 0.044715f * x * x * x);
                        const float sg = __builtin_amdgcn_rcpf(1.0f + __builtin_amdgcn_exp2f(-1.4426950408889634f * arg));
                        v[j] = isg ? sg : x * sg; }
                    u32x4 w; w.x = cvt_pk_bf16(v[0], v[1]); w.y = cvt_pk_bf16(v[2], v[3]); w.z = cvt_pk_bf16(v[4], v[5]); w.w = cvt_pk_bf16(v[6], v[7]);
                    *(u32x4*)(rowp + bj * HALF) = w; } }
    }
};
template <int ACT> struct EpiBf {
    static constexpr bool PERM = true, AFTER_DRAIN = false, CHAIN = false;
    bf16_t* O; int ldc;
    __device__ __forceinline__ void operator()(const f32x4 (&acc)[2][2][4][2], const Unit& u, int wr, int wc, int fr, int fq) const {
        const int row0 = u.pm * BM + wr * 64 + fr; const int col0 = u.pn * BM + wc * 32 + 8 * fq;
#pragma unroll
        for (int ai = 0; ai < 2; ++ai)
#pragma unroll
            for (int m = 0; m < 4; ++m) { bf16_t* rowp = O + (size_t)(row0 + ai * HALF + m * 16) * ldc + col0;
#pragma unroll
                for (int bj = 0; bj < 2; ++bj) { f32x4 v0 = acc[ai][bj][m][0], v1 = acc[ai][bj][m][1];
                    if (ACT == 1) {
#pragma unroll
                        for (int j = 0; j < 4; ++j) { const float a = fmaxf(v0[j], 0.f), b = fmaxf(v1[j], 0.f); v0[j] = a * a; v1[j] = b * b; } }
                    u32x4 w; w.x = cvt_pk_bf16(v0[0], v0[1]); w.y = cvt_pk_bf16(v0[2], v0[3]); w.z = cvt_pk_bf16(v1[0], v1[1]); w.w = cvt_pk_bf16(v1[2], v1[3]);
                    *(u32x4*)(rowp + bj * HALF) = w; } }
    }
};
struct EpiMix {
    static constexpr bool PERM = true, AFTER_DRAIN = false, CHAIN = true;
    const bf16_t* GT; bf16_t* MIX;
    __device__ __forceinline__ void mid(f32x4 (&acc)[2][2][4][2], const Unit& u, int wr, int wc, int fr, int fq) const {
        const int row0 = u.pm * BM + wr * 64 + fr; const int col0 = u.pn * BM + wc * 32 + 8 * fq;
#pragma unroll
        for (int ai = 0; ai < 2; ++ai)
#pragma unroll
            for (int m = 0; m < 4; ++m) { const bf16_t* gp = GT + (size_t)(row0 + ai * HALF + m * 16) * 2048 + col0;
#pragma unroll
                for (int bj = 0; bj < 2; ++bj) { const u32x4 ga = *(const u32x4*)(gp + bj * HALF), gb = *(const u32x4*)(gp + 1024 + bj * HALF);
                    const unsigned gaw[4] = {ga.x, ga.y, ga.z, ga.w}, gbw[4] = {gb.x, gb.y, gb.z, gb.w};
#pragma unroll
                    for (int j = 0; j < 4; ++j) { const int n = j >> 1, e = (j & 1) * 2;
                        const float r0 = __uint_as_float(gaw[j] << 16) / fmaxf(__uint_as_float(gbw[j] << 16), 1e-30f);
                        const float r1 = __uint_as_float(gaw[j] & 0xffff0000u) / fmaxf(__uint_as_float(gbw[j] & 0xffff0000u), 1e-30f);
                        acc[ai][bj][m][n][e] *= r0; acc[ai][bj][m][n][e + 1] *= r1; } } }
    }
    __device__ __forceinline__ void operator()(const f32x4 (&acc)[2][2][4][2], const Unit& u, int wr, int wc, int fr, int fq) const {
        const int row0 = u.pm * BM + wr * 64 + fr; const int col0 = u.pn * BM + wc * 32 + 8 * fq;
#pragma unroll
        for (int ai = 0; ai < 2; ++ai)
#pragma unroll
            for (int m = 0; m < 4; ++m) { const size_t r = (size_t)(row0 + ai * HALF + m * 16); const bf16_t* gp = GT + r * 2048 + 1024 + col0; bf16_t* op = MIX + r * 1024 + col0;
#pragma unroll
                for (int bj = 0; bj < 2; ++bj) { const u32x4 gb = *(const u32x4*)(gp + bj * HALF); const unsigned gbw[4] = {gb.x, gb.y, gb.z, gb.w}; unsigned ow[4];
#pragma unroll
                    for (int j = 0; j < 4; ++j) { const int n = j >> 1, e = (j & 1) * 2;
                        const float g0 = fmaxf(__uint_as_float(gbw[j] << 16), 1e-30f), g1 = fmaxf(__uint_as_float(gbw[j] & 0xffff0000u), 1e-30f);
                        ow[j] = cvt_pk_bf16(acc[ai][bj][m][n][e] * g0, acc[ai][bj][m][n][e + 1] * g1); }
                    u32x4 w; w.x = ow[0]; w.y = ow[1]; w.z = ow[2]; w.w = ow[3];
                    *(u32x4*)(op + bj * HALF) = w; } }
    }
};
struct EpiF32 {
    static constexpr bool PERM = false, AFTER_DRAIN = false, CHAIN = false;
    float* C; int ldc;
    __device__ __forceinline__ void operator()(const f32x4 (&acc)[2][2][4][2], const Unit& u, int wr, int wc, int fr, int fq) const {
        const int row0 = u.pm * BM + wr * 64 + fr, col0 = u.pn * BM + wc * 32 + 4 * fq;
#pragma unroll
        for (int ai = 0; ai < 2; ++ai)
#pragma unroll
            for (int m = 0; m < 4; ++m) { float* rowp = C + (size_t)(row0 + ai * HALF + m * 16) * ldc + col0;
#pragma unroll
                for (int bj = 0; bj < 2; ++bj)
#pragma unroll
                    for (int n = 0; n < 2; ++n) *(f32x4*)(rowp + bj * HALF + n * 16) = acc[ai][bj][m][n]; }
    }
};
}

struct Args { const float* in[24]; float* out; unsigned char* ws; };
struct Frame {
    LAS unsigned char* lds;
    int tid, lane, wave, G, bid;
};

__device__ __forceinline__ void p0_transpose_item(const float* W, int K, int N, bf16* WT, bf16* WT2, int mode, LAS float* scr, int item, int lane) {
    const int nblk = N / 32, kb = item / nblk, nb = item % nblk, k0 = 64 * kb, n0 = 32 * nb;
#pragma unroll 8
    for (int i = 0; i < 32; ++i) { const int kk = 2 * i + (lane >> 5); scr[kk * 33 + (lane & 31)] = W[(size_t)(k0 + kk) * N + n0 + (lane & 31)]; }
    LDS_WAIT(); asm volatile("" ::: "memory");
    bf16* dst = WT; int r0 = n0;
    if (mode == 1) { if (n0 < 1024) { r0 = n0; } else if (n0 < 2560) { dst = WT2; r0 = n0 - 1024; } else { r0 = n0 - 2560 + 1024; } }
    const int c = lane & 7;
#pragma unroll
    for (int j = 0; j < 4; ++j) { const int n = (lane >> 3) + 8 * j; const LAS float* s = scr + (8 * c) * 33 + n;
        v4u o; o.x = pk2(s[0 * 33], s[1 * 33]); o.y = pk2(s[2 * 33], s[3 * 33]); o.z = pk2(s[4 * 33], s[5 * 33]); o.w = pk2(s[6 * 33], s[7 * 33]);
        *(v4u*)(dst + (size_t)(r0 + n) * K + k0 + 8 * c) = o; }
    LDS_WAIT(); asm volatile("" ::: "memory");
}
__device__ __forceinline__ void rms_row_to_bf16(const float* xrow, const float* g, bf16* orow, int lane) {
    const f32x4* xr = (const f32x4*)xrow + lane; const f32x4* gr = (const f32x4*)g + lane;
    f32x4 v[4]; float s = 0.f;
#pragma unroll
    for (int j = 0; j < 4; ++j) { v[j] = xr[64 * j]; s += (v[j].x * v[j].x + v[j].y * v[j].y) + (v[j].z * v[j].z + v[j].w * v[j].w); }
    const float r = 1.0f / sqrtf(wave_sum(s) * (1.f / D) + EPS);
    unsigned long long* o8 = (unsigned long long*)orow + lane;
#pragma unroll
    for (int j = 0; j < 4; ++j) { const f32x4 gg = gr[64 * j]; o8[64 * j] = (unsigned long long)pk2(v[j].x * r * gg.x, v[j].y * r * gg.y) | ((unsigned long long)pk2(v[j].z * r * gg.z, v[j].w * r * gg.w) << 32); }
}
__device__ __forceinline__ void filt_hidden(const Args& a, int l, int lane, float* H2) {
    const float* w1 = a.in[9]; const float* b1 = a.in[10]; const float* f1 = a.in[11]; const float* w2 = a.in[12]; const float* b2 = a.in[13]; const float* f2 = a.in[14];
    const float tpos = (float)l / (float)(SEQ - 1);
    const float w = 6.283185307179586f * (float)l / (float)SEQ;
    float feat = 0.f;
    if (lane == 0) feat = tpos;
    else if (lane < 33) { const int k = (lane - 1) & 15; const float fr = 1e-4f + (float)k * ((15.0f - 1e-4f) / 15.0f); const float ang = fr * w; feat = (lane <= 16) ? cosf(ang) : -sinf(ang); }
    float pre = b1[lane];
    for (int i = 0; i < FE; ++i) pre += __shfl(feat, i) * w1[i * FH + lane];
    const float h1 = sinf(f1[lane] * pre);
    float pre2 = b2[lane];
    for (int i = 0; i < FH; ++i) pre2 += __shfl(h1, i) * w2[i * FH + lane];
    H2[l * FH + lane] = sinf(f2[lane] * pre2);
}
__device__ __forceinline__ void p0_prologue(const Args& a, Frame& F) {
    LAS float* scr = (LAS float*)(F.lds + F.wave * 16384);
    const int gw = F.bid * NWAVES + F.wave, NGW = F.G * NWAVES;
    unsigned char* ws = a.ws;
    constexpr int I_IN = (D / 64) * (INC / 32), I_A = (AW / 64) * (D / 32), I_B = I_A, I_O = (D / 64) * (D / 32), I_1 = (D / 64) * (FF / 32), I_2 = (FF / 64) * (D / 32);
    constexpr int NITEMS = I_IN + I_A + I_B + I_O + I_1 + I_2;
    for (int it = gw; it < NITEMS; it += NGW) {
        int r = it;
        if (r < I_IN) { p0_transpose_item(a.in[2], D, INC, (bf16*)(ws + WS_WAG), (bf16*)(ws + WS_WPB), 1, scr, r, F.lane); continue; } r -= I_IN;
        if (r < I_A) { p0_transpose_item(a.in[6], AW, D, (bf16*)(ws + WS_WA), nullptr, 0, scr, r, F.lane); continue; } r -= I_A;
        if (r < I_B) { p0_transpose_item(a.in[17], BW, D, (bf16*)(ws + WS_WB), nullptr, 0, scr, r, F.lane); continue; } r -= I_B;
        if (r < I_O) { p0_transpose_item(a.in[18], D, D, (bf16*)(ws + WS_WO), nullptr, 0, scr, r, F.lane); continue; } r -= I_O;
        if (r < I_1) { p0_transpose_item(a.in[21], D, FF, (bf16*)(ws + WS_W1), nullptr, 0, scr, r, F.lane); continue; } r -= I_1;
        p0_transpose_item(a.in[22], FF, D, (bf16*)(ws + WS_W2), nullptr, 0, scr, r, F.lane);
    }
    for (int m = gw; m < T; m += NGW) rms_row_to_bf16(a.in[0] + (size_t)m * D, a.in[1], (bf16*)(ws + WS_XN) + (size_t)m * D, F.lane);
    for (int l = gw; l < SEQ; l += NGW) filt_hidden(a, l, F.lane, (float*)(ws + WS_H2));
    { const float* wsf = a.in[4]; bf16* wsb = (bf16*)(ws + WS_WSB); const int gt = F.bid * NTHR + F.tid;
      for (int i = gt; i < NG * CHUNK * CHUNK / 4; i += F.G * NTHR) { const f32x4 v = ((const f32x4*)wsf)[i]; v2u o; o.x = pk2(v.x, v.y); o.y = pk2(v.z, v.w); ((v2u*)wsb)[i] = o; } }
}

__device__ __forceinline__ void filt_raw_item(const Args& a, int item, int lane, const float* H2, float* HF, float* SSP) {
    const int lb = item >> 7, cb = item & 127; const int l = lb * 64 + lane;
    const float* w3 = a.in[15];
    f32x4 h[16];
#pragma unroll
    for (int j = 0; j < 16; ++j) h[j] = ((const f32x4*)(H2 + (size_t)l * FH))[j];
    const float tpos = (float)l / (float)(SEQ - 1);
    const float min_decay = -3.0701134573253945f, max_decay = -15.350567286626973f;
    for (int cc = 0; cc < 16; ++cc) {
        const int col = cb * 16 + cc; float acc = 0.f;
#pragma unroll
        for (int j = 0; j < 16; ++j) { acc += h[j].x * w3[(4 * j + 0) * 2048 + col]; acc += h[j].y * w3[(4 * j + 1) * 2048 + col]; acc += h[j].z * w3[(4 * j + 2) * 2048 + col]; acc += h[j].w * w3[(4 * j + 3) * 2048 + col]; }
        const int c = col & 511; const float delta = fabsf(min_decay + (float)c * ((max_decay - min_decay) / 511.0f));
        const float v = acc * (expf(-tpos * delta) + 0.05f);
        HF[(size_t)col * SEQ + l] = v;
        const float ss = wave_sum(v * v);
        if (lane == 0) SSP[lb * 2048 + col] = ss;
    }
}

constexpr int VN_STATS_OFF = 70144;
__device__ __forceinline__ int vn_off(int row, int tok) { return row * 272 + (row >> 3) * 16 + tok * 2; }
__device__ __forceinline__ void spatial_unit(const Args& a, Frame& F, int ua) {
    unsigned char* ws = a.ws;
    const bf16* ZA = (const bf16*)(ws + WS_ZA); bf16* YA = (bf16*)(ws + WS_YA); const bf16* WSB = (const bf16*)(ws + WS_WSB);
    const float* vgain = a.in[3]; const float* bs = a.in[5];
    const int bc = ua >> 1, half = ua & 1, t0 = bc * CHUNK;
    LAS float* stats = (LAS float*)(F.lds + VN_STATS_OFF);
    for (int i = 0; i < 16; ++i) { const int tok = F.wave * 16 + i;
        const v4u raw = *(const v4u*)(ZA + (size_t)(t0 + tok) * 1024 + 512 + F.lane * 8);
        float x[8] = {bflo(raw.x), bfhi(raw.x), bflo(raw.y), bfhi(raw.y), bflo(raw.z), bfhi(raw.z), bflo(raw.w), bfhi(raw.w)};
        float s = 0.f;
#pragma unroll
        for (int j = 0; j < 8; ++j) s += x[j];
        const float mean = wave_sum(s) * (1.f / 512.f); float q = 0.f;
#pragma unroll
        for (int j = 0; j < 8; ++j) { const float d = x[j] - mean; q += d * d; }
        const float rstd = 1.0f / sqrtf(wave_sum(q) * (1.f / 512.f) + EPS);
        if (F.lane == 0) { stats[2 * tok] = mean; stats[2 * tok + 1] = rstd; } }
    __syncthreads();
    for (int it = 0; it < 8; ++it) {
        const int task = it * NTHR + F.tid;
        const int ch8 = (task & 7) + ((task >> 6) & 3) * 8, tok = ((task >> 3) & 7) + (task >> 8) * 8;
        const int ch = ch8 * 8;
        const v4u raw = *(const v4u*)(ZA + (size_t)(t0 + tok) * 1024 + 512 + half * 256 + ch);
        const float mean = stats[2 * tok], rstd = stats[2 * tok + 1];
        const float* gp = vgain + half * 256 + ch;
        float x[8] = {bflo(raw.x), bfhi(raw.x), bflo(raw.y), bfhi(raw.y), bflo(raw.z), bfhi(raw.z), bflo(raw.w), bfhi(raw.w)};
#pragma unroll
        for (int j = 0; j < 8; ++j) { const float v = (x[j] - mean) * rstd * gp[j]; *(LAS unsigned short*)(F.lds + vn_off(ch + j, tok)) = (unsigned short)f2bf(v); }
    }
    __syncthreads();
    const int fr = F.lane & 15, fq = F.lane >> 4;
    const int tl = F.wave * 16 + fr;
    for (int gl = 0; gl < 4; ++gl) { const int g = half * 4 + gl;
        bf16x8 Y[4];
#pragma unroll
        for (int ks = 0; ks < 4; ++ks) Y[ks] = *(const bf16x8*)(WSB + ((size_t)g * CHUNK + tl) * CHUNK + ks * 32 + fq * 8);
        const float bsv = bs[g * CHUNK + tl];
#pragma unroll
        for (int dt = 0; dt < 4; ++dt) { f32x4 acc = {0.f, 0.f, 0.f, 0.f};
#pragma unroll
            for (int ks = 0; ks < 4; ++ks) { const bf16x8 X = *(const LAS bf16x8*)(F.lds + vn_off(gl * 64 + dt * 16 + fr, ks * 32 + fq * 8));
                acc = __builtin_amdgcn_mfma_f32_16x16x32_bf16(X, Y[ks], acc, 0, 0, 0); }
            const int chn = half * 256 + gl * 64 + dt * 16 + fq * 4;
            const v2u uraw = *(const v2u*)(ZA + (size_t)(t0 + tl) * 1024 + chn);
            v2u o; o.x = pk2(bflo(uraw.x) * (acc[0] + bsv), bfhi(uraw.x) * (acc[1] + bsv)); o.y = pk2(bflo(uraw.y) * (acc[2] + bsv), bfhi(uraw.y) * (acc[3] + bsv));
            *(v2u*)(YA + (size_t)(t0 + tl) * 512 + chn) = o; } }
    __syncthreads();
}

constexpr int FC_STRIDE = 8480, ZB_OFF = 8 * FC_STRIDE, ZB_STRIDE = 5136;
template <int ORD>
__device__ __forceinline__ void conv_unit(const Args& a, Frame& F, int c) {
    unsigned char* ws = a.ws;
    const bf16* PBT = (const bf16*)(ws + WS_PBT);
    const float* HF = a.out; const float* SSP = (const float*)(ws + WS_SSP);
    const float* cw = a.in[7]; const float* cb = a.in[8];
    const int tid = F.tid, lane = F.lane, w = F.wave;
    float ssum = 0.f;
    if (lane < 32) ssum = SSP[lane * 2048 + (ORD * 2 + 0) * 512 + c] + SSP[lane * 2048 + (ORD * 2 + 1) * 512 + c];
    const float fscale = 1.0f / sqrtf(wave_sum(ssum) + EPS);
    const float* hfw = HF + (size_t)((ORD * 2 + 0) * 512 + c) * SEQ; const float* hbw = HF + (size_t)((ORD * 2 + 1) * 512 + c) * SEQ;
    for (int p = tid; p < 4232; p += NTHR) {
        const int gi = 2048 - p; float v = 0.f;
        if (gi >= -2047 && gi <= 2047) { v = gi > 0 ? hfw[gi] : (gi < 0 ? hbw[-gi] : hfw[0] + hbw[0]); v *= fscale; }
        const unsigned short hv = (unsigned short)f2bf(v);
#pragma unroll
        for (int r = 0; r < 8; ++r) *(LAS unsigned short*)(F.lds + r * FC_STRIDE + (p + r) * 2) = hv;
    }
    if (tid < 8) {
        for (int x = 0; x < tid; ++x) *(LAS unsigned short*)(F.lds + tid * FC_STRIDE + x * 2) = 0; }
    const bf16* zsrc = (ORD == 0) ? PBT + (size_t)(1024 + c) * T : (const bf16*)(ws + WS_Z1T) + (size_t)c * T;
    const float w0 = cw[0 * 1536 + 1024 + c], w1 = cw[1 * 1536 + 1024 + c], w2 = cw[2 * 1536 + 1024 + c], wb = cb[1024 + c];
    for (int i = tid; i < 8 * 64; i += NTHR) { const int b = i >> 6, k = i & 63; const int tt = (k < 32) ? k * 8 : 2304 + (k - 32) * 8;
        *(LAS v4u*)(F.lds + ZB_OFF + b * ZB_STRIDE + tt * 2) = (v4u){0u, 0u, 0u, 0u}; }
    for (int i = tid; i < T / 8; i += NTHR) { const int b = i >> 8, t0 = (i & 255) * 8;
        const v4u raw = *(const v4u*)(zsrc + (size_t)b * SEQ + t0);
        v4u o = raw;
        if (ORD == 0) {
            float x[10]; x[1] = bflo(raw.x); x[2] = bfhi(raw.x); x[3] = bflo(raw.y); x[4] = bfhi(raw.y); x[5] = bflo(raw.z); x[6] = bfhi(raw.z); x[7] = bflo(raw.w); x[8] = bfhi(raw.w);
            x[0] = t0 > 0 ? bf2f(zsrc[(size_t)b * SEQ + t0 - 1]) : 0.f; x[9] = t0 + 8 < SEQ ? bf2f(zsrc[(size_t)b * SEQ + t0 + 8]) : 0.f;
            float y[8];
#pragma unroll
            for (int j = 0; j < 8; ++j) y[j] = w0 * x[j] + w1 * x[j + 1] + w2 * x[j + 2] + wb;
            o.x = pk2(y[0], y[1]); o.y = pk2(y[2], y[3]); o.z = pk2(y[4], y[5]); o.w = pk2(y[6], y[7]);
        }
        *(LAS v4u*)(F.lds + ZB_OFF + b * ZB_STRIDE + (t0 + 256) * 2) = o; }
    __syncthreads();
    const int fr = lane & 15, fq = lane >> 4;
    const int batch = fr & 7, il = fr >> 3;
    const int abase = (fr & 7) * FC_STRIDE + 2 * (2048 - 16 * (16 * w - 128 + (fq >> 1)) - 8 * (fr >> 3) + 8 * (fq & 1));
    const int bbase = ZB_OFF + batch * ZB_STRIDE + 2 * (16 * (128 + il - (fq >> 1)) + 8 * (fq & 1) + 256);
    f32x4 acc[8];
#pragma unroll
    for (int i = 0; i < 8; ++i) acc[i] = (f32x4){0.f, 0.f, 0.f, 0.f};
    bf16x8 R[8];
#pragma unroll
    for (int m = 1; m < 8; ++m) R[m] = *(const LAS bf16x8*)(F.lds + bbase + 64 * m);
    for (int s8 = 0; s8 < 72; s8 += 8) {
#pragma unroll
        for (int ss = 0; ss < 8; ++ss) { const int s = s8 + ss;
            R[(8 - ss) & 7] = *(const LAS bf16x8*)(F.lds + bbase - 64 * s);
            const bf16x8 Af = *(const LAS bf16x8*)(F.lds + abase - 64 * s);
#pragma unroll
            for (int tau = 0; tau < 8; ++tau) acc[tau] = __builtin_amdgcn_mfma_f32_16x16x32_bf16(Af, R[(tau - ss + 8) & 7], acc[tau], 0, 0, 0);
        }
    }
    const float skip = a.in[16][ORD * 512 + c];
    const int gch = (ORD == 0) ? c : 512 + c;
    const bf16* gsrc = PBT + (size_t)gch * T + (size_t)batch * SEQ;
    const float g0 = cw[0 * 1536 + gch], g1 = cw[1 * 1536 + gch], g2 = cw[2 * 1536 + gch], gb = cb[gch];
    bf16* dst = ((ORD == 0) ? (bf16*)(ws + WS_Z1T) : (bf16*)(ws + WS_YBT)) + (size_t)c * T + (size_t)batch * SEQ;
#pragma unroll
    for (int tau = 0; tau < 8; ++tau) { const int t = 16 * (16 * w + 2 * tau + il) + 4 * fq;
        const v2u zr = *(const LAS v2u*)(F.lds + ZB_OFF + batch * ZB_STRIDE + (t + 256) * 2);
        const v2u gr = *(const v2u*)(gsrc + t);
        float x[6]; x[1] = bflo(gr.x); x[2] = bfhi(gr.x); x[3] = bflo(gr.y); x[4] = bfhi(gr.y);
        x[0] = t > 0 ? bf2f(gsrc[t - 1]) : 0.f; x[5] = t + 4 < SEQ ? bf2f(gsrc[t + 4]) : 0.f;
        const float z4[4] = {bflo(zr.x), bfhi(zr.x), bflo(zr.y), bfhi(zr.y)}; float y[4];
#pragma unroll
        for (int r = 0; r < 4; ++r) { const float gate = g0 * x[r] + g1 * x[r + 1] + g2 * x[r + 2] + gb; y[r] = gate * (acc[tau][r] + skip * z4[r]); }
        v2u o; o.x = pk2(y[0], y[1]); o.y = pk2(y[2], y[3]);
        *(v2u*)(dst + t) = o; }
    __syncthreads();
}

__device__ __forceinline__ void transpose_item(const Args& a, Frame& F, int item) {
    const bf16* src = (const bf16*)(a.ws + WS_YBT); bf16* dst = (bf16*)(a.ws + WS_YB);
    LAS unsigned short* tile = (LAS unsigned short*)(F.lds + F.wave * 16384);
    const int cblk = item & 7, tblk = item >> 3, c0 = cblk * 64, t0 = tblk * 64, lane = F.lane;
#pragma unroll
    for (int it = 0; it < 16; ++it) { const int ch = it * 4 + (lane >> 4), tk = (lane & 15) * 4;
        const v2u v = *(const v2u*)(src + (size_t)(c0 + ch) * T + t0 + tk);
        *(LAS v2u*)(tile + ch * 68 + tk) = v; }
    LDS_WAIT(); asm volatile("" ::: "memory");
#pragma unroll
    for (int it = 0; it < 8; ++it) { const int tok = it * 8 + (lane >> 3), c8 = (lane & 7) * 8; unsigned short e[8];
#pragma unroll
        for (int k = 0; k < 8; ++k) e[k] = tile[(c8 + k) * 68 + tok];
        v4u o; o.x = e[0] | ((unsigned)e[1] << 16); o.y = e[2] | ((unsigned)e[3] << 16); o.z = e[4] | ((unsigned)e[5] << 16); o.w = e[6] | ((unsigned)e[7] << 16);
        *(v4u*)(dst + (size_t)(t0 + tok) * 512 + c0 + c8) = o; }
    LDS_WAIT(); asm volatile("" ::: "memory");
}

__device__ __forceinline__ void post_mix_row(const Args& a, int row, int lane) {
    float* mrow = a.out + (size_t)row * D; const float* xrow = a.in[0] + (size_t)row * D; bf16* hn = (bf16*)(a.ws + WS_XN) + (size_t)row * D;
    const f32x4* g1 = (const f32x4*)a.in[19] + lane; const f32x4* g2 = (const f32x4*)a.in[20] + lane;
    f32x4 m[4], h[4]; float s = 0.f;
#pragma unroll
    for (int j = 0; j < 4; ++j) { m[j] = ((const f32x4*)mrow + lane)[64 * j]; s += (m[j].x * m[j].x + m[j].y * m[j].y) + (m[j].z * m[j].z + m[j].w * m[j].w); }
    const float r1 = 1.0f / sqrtf(wave_sum(s) * (1.f / D) + EPS); float s2 = 0.f;
#pragma unroll
    for (int j = 0; j < 4; ++j) { const f32x4 x = ((const f32x4*)xrow + lane)[64 * j]; h[j] = x + m[j] * r1 * g1[64 * j]; s2 += (h[j].x * h[j].x + h[j].y * h[j].y) + (h[j].z * h[j].z + h[j].w * h[j].w); }
    const float r2 = 1.0f / sqrtf(wave_sum(s2) * (1.f / D) + EPS);
#pragma unroll
    for (int j = 0; j < 4; ++j) { ((f32x4*)mrow + lane)[64 * j] = h[j]; const f32x4 gg = g2[64 * j];
        ((unsigned long long*)hn + lane)[64 * j] = (unsigned long long)pk2(h[j].x * r2 * gg.x, h[j].y * r2 * gg.y) | ((unsigned long long)pk2(h[j].z * r2 * gg.z, h[j].w * r2 * gg.w) << 32); }
}
__device__ __forceinline__ void post_ffn_row(const Args& a, int row, int lane) {
    float* hrow = a.out + (size_t)row * D; const float* frow = (const float*)(a.ws + WS_F) + (size_t)row * D;
    const f32x4* g3 = (const f32x4*)a.in[23] + lane;
    f32x4 f[4]; float s = 0.f;
#pragma unroll
    for (int j = 0; j < 4; ++j) { f[j] = ((const f32x4*)frow + lane)[64 * j]; s += (f[j].x * f[j].x + f[j].y * f[j].y) + (f[j].z * f[j].z + f[j].w * f[j].w); }
    const float r = 1.0f / sqrtf(wave_sum(s) * (1.f / D) + EPS);
#pragma unroll
    for (int j = 0; j < 4; ++j) { const f32x4 h = ((const f32x4*)hrow + lane)[64 * j]; ((f32x4*)hrow + lane)[64 * j] = h + f[j] * r * g3[64 * j]; }
}

__global__ void __launch_bounds__(NTHR, 2) fwd_megakernel(Args args) {
    extern __shared__ __attribute__((aligned(16))) unsigned char lds_raw[];
    cg::grid_group grid = cg::this_grid();
    Frame F; F.lds = (LAS unsigned char*)lds_raw; F.tid = threadIdx.x; F.lane = F.tid & 63; F.wave = __builtin_amdgcn_readfirstlane(F.tid >> 6); F.G = gridDim.x; F.bid = blockIdx.x;
    unsigned char* ws = args.ws;
    const int gw = F.bid * NWAVES + F.wave, NGW = F.G * NWAVES;
#define GRID_BAR() grid.sync()

    p0_prologue(args, F);
    GRID_BAR();
    {
        pg8::Gemm g{(const bf16*)(ws + WS_XN), (const bf16*)(ws + WS_WAG), nullptr, nullptr, T, 3072, D}; pg8::StaticOrder S; S.init(T, 3072, F.G, F.bid);
        pg8::EpiInA E{(bf16*)(ws + WS_ZA), (bf16*)(ws + WS_GATES)};
        pg8::gemm_phase<pg8::EpiInA, pg8::StaticOrder, true, true>(F.lds, g, S, E);
    }
    {
        pg8::Gemm g{(const bf16*)(ws + WS_WPB), (const bf16*)(ws + WS_XN), nullptr, nullptr, 1536, T, D}; pg8::StaticOrder S; S.init(1536, T, F.G, F.bid);
        pg8::EpiBf<0> E{(bf16*)(ws + WS_PBT), T};
        pg8::gemm_phase<pg8::EpiBf<0>, pg8::StaticOrder, true, true>(F.lds, g, S, E);
    }
    for (int it = gw; it < 32 * 128; it += NGW) filt_raw_item(args, it, F.lane, (const float*)(ws + WS_H2), args.out, (float*)(ws + WS_SSP));
    GRID_BAR();
    for (int u = F.bid; u < 256; u += F.G) spatial_unit(args, F, u);
    for (int c = F.bid; c < BW; c += F.G) conv_unit<0>(args, F, c);
    GRID_BAR();
    for (int c = F.bid; c < BW; c += F.G) conv_unit<1>(args, F, c);
    GRID_BAR();
    for (int it = gw; it < 8 * (T / 64); it += NGW) transpose_item(args, F, it);
    GRID_BAR();
    {
        pg8::Gemm g{(const bf16*)(ws + WS_YA), (const bf16*)(ws + WS_WA), (const bf16*)(ws + WS_YB), (const bf16*)(ws + WS_WB), T, D, 512}; pg8::ChainOrder S; S.init(T, D, F.G, F.bid);
        pg8::EpiMix E{(const bf16*)(ws + WS_GATES), (bf16*)(ws + WS_MIX)};
        pg8::gemm_phase<pg8::EpiMix, pg8::ChainOrder, false, true>(F.lds, g, S, E);
    }
    GRID_BAR();
    {
        pg8::Gemm g{(const bf16*)(ws + WS_MIX), (const bf16*)(ws + WS_WO), nullptr, nullptr, T, D, D}; pg8::StaticOrder S; S.init(T, D, F.G, F.bid);
        pg8::EpiF32 E{args.out, D};
        pg8::gemm_phase<pg8::EpiF32, pg8::StaticOrder, false, true>(F.lds, g, S, E);
    }
    GRID_BAR();
    for (int m = gw; m < T; m += NGW) post_mix_row(args, m, F.lane);
    GRID_BAR();
    {
        pg8::Gemm g{(const bf16*)(ws + WS_XN), (const bf16*)(ws + WS_W1), nullptr, nullptr, T, FF, D}; pg8::StaticOrder S; S.init(T, FF, F.G, F.bid);
        pg8::EpiBf<1> E{(bf16*)(ws + WS_F1), FF};
        pg8::gemm_phase<pg8::EpiBf<1>, pg8::StaticOrder, true, true>(F.lds, g, S, E);
    }
    GRID_BAR();
    {
        pg8::Gemm g{(const bf16*)(ws + WS_F1), (const bf16*)(ws + WS_W2), nullptr, nullptr, T, D, FF}; pg8::StaticOrder S; S.init(T, D, F.G, F.bid);
        pg8::EpiF32 E{(float*)(ws + WS_F), D};
        pg8::gemm_phase<pg8::EpiF32, pg8::StaticOrder, false, true>(F.lds, g, S, E);
    }
    GRID_BAR();
    for (int m = gw; m < T; m += NGW) post_ffn_row(args, m, F.lane);
}

extern "C" void kernel_launch(void* const* d_in, const int* in_sizes, int n_in, void* d_out, int out_size, void* d_ws, size_t ws_size, hipStream_t stream) {
    static int grid = 0;
    if (grid == 0) {
        if (n_in != 24 || in_sizes[0] != T * D || out_size != T * D || ws_size < WS_END) { fprintf(stderr, "kernel_launch: unexpected shapes (n_in %d, in0 %d, out %d, ws %zu); nothing launched\n", n_in, n_in > 0 ? in_sizes[0] : -1, out_size, ws_size); grid = -1; return; }
        int dev = 0, cus = 0, per_cu = 0;
        hipGetDevice(&dev); hipDeviceGetAttribute(&cus, hipDeviceAttributeMultiprocessorCount, dev);
        if (hipFuncSetAttribute((const void*)fwd_megakernel, hipFuncAttributeMaxDynamicSharedMemorySize, LDS_BYTES) != hipSuccess) { fprintf(stderr, "kernel_launch: hipFuncSetAttribute failed\n"); grid = -1; return; }
        hipOccupancyMaxActiveBlocksPerMultiprocessor(&per_cu, (const void*)fwd_megakernel, NTHR, LDS_BYTES);
        (void)hipGetLastError();
        if (per_cu < 1) { fprintf(stderr, "kernel_launch: occupancy query says %d blocks per CU\n", per_cu); per_cu = 1; }
        grid = cus;
    }
    if (grid < 0) return;
    Args a{};
    for (int i = 0; i < 24; ++i) a.in[i] = (const float*)d_in[i];
    a.out = (float*)d_out; a.ws = (unsigned char*)d_ws;
    void* kargs[] = {&a};
    hipError_t e = hipLaunchCooperativeKernel((const void*)fwd_megakernel, dim3(grid), dim3(NTHR), kargs, LDS_BYTES, stream);
    if (e != hipSuccess) fprintf(stderr, "cooperative launch failed: %s (grid %d)\n", hipGetErrorString(e), grid);
}
```

```cpp
#include <hip/hip_runtime.h>
#include <hip/hip_cooperative_groups.h>
#include <cstdio>
#include <cstdint>
namespace cg = cooperative_groups;
namespace pg8 {
#define PG8_LAS __attribute__((address_space(3)))
typedef unsigned short bf16_t;
typedef short bf16x8 __attribute__((ext_vector_type(8)));
typedef float f32x4 __attribute__((ext_vector_type(4)));
typedef unsigned u32x4 __attribute__((ext_vector_type(4)));
constexpr int BM = 256, BK = 64, HALF = 128, HTB = HALF * BK * 2  , STAGE_BYTES = 8 * HTB, NXCD = 8, WGM = 8;

__host__ __device__ __forceinline__ int lds_byte(int r, int c) { const int st = (r >> 4) * 2 + (c >> 5), rr = r & 15, cc = c & 31, ob = rr * 64 + cc * 2; return st * 1024 + (ob ^ (((ob >> 9) & 1) << 5)); }
__host__ __device__ __forceinline__ void stage_rc(int b, int& R, int& C) { const int st = b / 1024, sb = b % 1024, swz = sb ^ (((sb >> 9) & 1) << 5); R = (st >> 1) * 16 + swz / 64; C = (st & 1) * 32 + (swz % 64) / 2; }
__host__ __device__ __forceinline__ int perm32(int rho) { const int n = rho >> 4, i = rho & 15; return 8 * (i >> 2) + 4 * n + (i & 3); }
__device__ __forceinline__ unsigned cvt_pk_bf16(float lo, float hi) { unsigned r; asm volatile("v_cvt_pk_bf16_f32 %0, %1, %2" : "=v"(r) : "v"(lo), "v"(hi)); return r; }
typedef float f32x2 __attribute__((ext_vector_type(2)));

struct Unit { int pm, pn, sel; };
struct Gemm { const bf16_t* A; const bf16_t* Bt; const bf16_t* A2; const bf16_t* Bt2; int M, N, K; };
template <int CH> struct OrderT {
    int nM, nN, nwg, G, c;
    __host__ __device__ void init(int M, int N, int G_, int c_) { nM = M / BM; nN = N / BM; nwg = nM * nN; G = G_; c = c_; }
    __host__ __device__ bool next(int i, Unit& u) const {
        const long L = (long)(i / CH) * G + c; if (L >= nwg) return false;
        int wgid = (int)L; { const int q = nwg / NXCD, r = nwg % NXCD, xcd = wgid % NXCD, off = wgid / NXCD; wgid = (xcd < r ? xcd * (q + 1) : r * (q + 1) + (xcd - r) * q) + off; }
        const int nig = WGM * nN, gid = wgid / nig, fm = gid * WGM, gsz = (nM - fm) < WGM ? (nM - fm) : WGM;
        u.pm = fm + ((wgid % nig) % gsz); u.pn = (wgid % nig) / gsz; u.sel = i % CH; return true;
    }
    __device__ __forceinline__ void a_ready(const Unit&) const {}
    __device__ __forceinline__ void done(const Unit&) const {}
};
typedef OrderT<1> StaticOrder;
typedef OrderT<2> ChainOrder;

template <class Epi, class Sched, bool ALIGN_EPI = false, bool SP2 = false>
__device__ __forceinline__ void gemm_phase(PG8_LAS unsigned char* lds, const Gemm g, const Sched& S, const Epi& E) {
    const int tid = threadIdx.x, wid = __builtin_amdgcn_readfirstlane(tid >> 6), lane = tid & 63, wr = wid >> 2, wc = wid & 3, fr = lane & 15, fq = lane >> 4;
    const int K = g.K, nt = K / BK;
    unsigned voffA[2], voffB[2];
#pragma unroll
    for (int i = 0; i < 2; ++i) { int R, C; stage_rc(tid * 16 + i * 8192, R, C); const int Rb = Epi::PERM ? ((R & ~31) + perm32(R & 31)) : R;
        voffA[i] = (unsigned)(R * K + C) * 2u; voffB[i] = (unsigned)(Rb * K + C) * 2u; }
    const size_t kstep = (size_t)(BK * 2);
    const size_t hstep = (size_t)HALF * K * 2;
    const size_t tstep = 2 * hstep;
    const unsigned ldsw = (unsigned)wid * 1024u;
    const int aoff = lds_byte(wr * 64 + fr, fq * 8), boff = lds_byte(wc * 32 + fr, fq * 8);
#define PG8_SA(b, h) (((b) * 2 + (h)) * HTB)
#define PG8_SB(b, h) ((4 + (b) * 2 + (h)) * HTB)
#define PG8_STAGE(bufoff, gbase, voff) do { _Pragma("unroll") for (int _i = 0; _i < 2; ++_i) \
        __builtin_amdgcn_global_load_lds((const unsigned*)((const char*)(gbase) + (voff)[_i]), (PG8_LAS unsigned*)(lds + (bufoff) + ldsw + _i * 8192), 16, 0, 0); } while (0)
#define PG8_LDA(dst, b, h) do { _Pragma("unroll") for (int m = 0; m < 4; ++m) _Pragma("unroll") for (int k = 0; k < 2; ++k) dst[m][k] = *(const PG8_LAS bf16x8*)(lds + PG8_SA(b, h) + aoff + m * 2048 + k * 1024); } while (0)
#define PG8_LDB(dst, b, h) do { _Pragma("unroll") for (int n = 0; n < 2; ++n) _Pragma("unroll") for (int k = 0; k < 2; ++k) dst[n][k] = *(const PG8_LAS bf16x8*)(lds + PG8_SB(b, h) + boff + n * 2048 + k * 1024); } while (0)
#define PG8_MMA(ai, bj, At, Bt) do { __builtin_amdgcn_s_setprio(1); _Pragma("unroll") for (int m = 0; m < 4; ++m) _Pragma("unroll") for (int n = 0; n < 2; ++n) _Pragma("unroll") for (int k = 0; k < 2; ++k) \
        acc[ai][bj][m][n] = __builtin_amdgcn_mfma_f32_16x16x32_bf16(Bt[n][k], At[m][k], acc[ai][bj][m][n], 0, 0, 0); __builtin_amdgcn_s_setprio(0); } while (0)
#define PG8_WAIT_V(n) asm volatile("s_waitcnt vmcnt(" #n ")" ::: "memory")
#define PG8_WAIT_L(n) asm volatile("s_waitcnt lgkmcnt(" #n ")" ::: "memory")
#define PG8_BAR __builtin_amdgcn_s_barrier()
#define PG8_SCHED __builtin_amdgcn_sched_barrier(0)
    Unit cur, nxt; int ui = 0;
    if (!S.next(0, cur)) return;
    f32x4 acc[2][2][4][2];
#pragma unroll
    for (int a = 0; a < 2; ++a)
#pragma unroll
        for (int b = 0; b < 2; ++b)
#pragma unroll
            for (int m = 0; m < 4; ++m)
#pragma unroll
                for (int n = 0; n < 2; ++n) acc[a][b][m][n] = (f32x4){0.f, 0.f, 0.f, 0.f};
    bf16x8 At[4][2], B0[2][2], B1[2][2];
    const char* cA = (const char*)(cur.sel ? g.A2 : g.A) + (size_t)cur.pm * tstep; const char* cB = (const char*)(cur.sel ? g.Bt2 : g.Bt) + (size_t)cur.pn * tstep;
    S.a_ready(cur);
    if constexpr (SP2) {
        PG8_STAGE(PG8_SB(0, 0), cB, voffB); PG8_STAGE(PG8_SB(0, 1), cB + hstep, voffB); PG8_STAGE(PG8_SA(0, 0), cA, voffA); PG8_STAGE(PG8_SA(0, 1), cA + hstep, voffA);
        if (wr == 1) PG8_BAR;
        PG8_WAIT_V(2); PG8_BAR;
        PG8_STAGE(PG8_SB(1, 0), cB + kstep, voffB); PG8_STAGE(PG8_SA(1, 0), cA + kstep, voffA); PG8_STAGE(PG8_SB(1, 1), cB + hstep + kstep, voffB);
        PG8_WAIT_V(6); PG8_BAR;
    } else {
        PG8_STAGE(PG8_SB(0, 0), cB, voffB); PG8_STAGE(PG8_SA(0, 0), cA, voffA); PG8_STAGE(PG8_SB(0, 1), cB + hstep, voffB); PG8_STAGE(PG8_SA(0, 1), cA + hstep, voffA);
        if (wr == 1) PG8_BAR;
        PG8_WAIT_V(4); PG8_BAR;
        PG8_STAGE(PG8_SB(1, 0), cB + kstep, voffB); PG8_STAGE(PG8_SA(1, 0), cA + kstep, voffA); PG8_STAGE(PG8_SB(1, 1), cB + hstep + kstep, voffB);
        PG8_WAIT_V(6); PG8_BAR;
    }
    for (;;) {
        const bool has_next = S.next(ui + 1, nxt);
        const char* nA = has_next ? (const char*)(nxt.sel ? g.A2 : g.A) + (size_t)nxt.pm * tstep : cA; const char* nB = has_next ? (const char*)(nxt.sel ? g.Bt2 : g.Bt) + (size_t)nxt.pn * tstep : cB;
        for (int t = 0; t < nt; t += 2) {
            const bool last = (t == nt - 2);
            const char* a1 = cA + (size_t)(t + 1) * kstep;
            const char* a2 = last ? nA : cA + (size_t)(t + 2) * kstep; const char* b2 = last ? nB : cB + (size_t)(t + 2) * kstep;
            const char* a3 = a2 + kstep; const char* b3 = b2 + kstep;
            if (last && has_next) S.a_ready(nxt);
            if constexpr (SP2) {
            PG8_LDB(B0, 0, 0); PG8_LDB(B1, 0, 1); PG8_SCHED; PG8_LDA(At, 0, 0); PG8_STAGE(PG8_SA(1, 1), a1 + hstep, voffA);
            PG8_WAIT_V(8); PG8_WAIT_L(0); PG8_BAR; PG8_MMA(0, 0, At, B0); PG8_MMA(0, 1, At, B1); PG8_BAR; PG8_SCHED;
            PG8_LDA(At, 0, 1); PG8_STAGE(PG8_SB(0, 0), b2, voffB); PG8_STAGE(PG8_SB(0, 1), b2 + hstep, voffB); PG8_STAGE(PG8_SA(0, 0), a2, voffA);
            PG8_WAIT_V(8); PG8_WAIT_L(0); PG8_BAR; PG8_MMA(1, 0, At, B0); PG8_MMA(1, 1, At, B1); PG8_BAR; PG8_SCHED;
            PG8_LDB(B0, 1, 0); PG8_LDB(B1, 1, 1); PG8_SCHED; PG8_LDA(At, 1, 0); PG8_STAGE(PG8_SA(0, 1), a2 + hstep, voffA);
            PG8_WAIT_V(8); PG8_WAIT_L(0); PG8_BAR; PG8_MMA(0, 0, At, B0); PG8_MMA(0, 1, At, B1); PG8_BAR; PG8_SCHED;
            PG8_LDA(At, 1, 1); PG8_STAGE(PG8_SB(1, 0), b3, voffB); PG8_STAGE(PG8_SB(1, 1), b3 + hstep, voffB); PG8_STAGE(PG8_SA(1, 0), a3, voffA);
            PG8_WAIT_V(8); PG8_WAIT_L(0); PG8_BAR; PG8_MMA(1, 0, At, B0); PG8_MMA(1, 1, At, B1); PG8_BAR; PG8_SCHED;
            } else {
            PG8_LDB(B0, 0, 0); PG8_SCHED; PG8_LDA(At, 0, 0); PG8_STAGE(PG8_SA(1, 1), a1 + hstep, voffA);
            PG8_WAIT_L(8); PG8_BAR; PG8_WAIT_L(0); PG8_MMA(0, 0, At, B0); PG8_BAR; PG8_SCHED;
            PG8_LDB(B1, 0, 1); PG8_STAGE(PG8_SB(0, 0), b2, voffB);
            PG8_BAR; PG8_WAIT_L(0); PG8_MMA(0, 1, At, B1); PG8_BAR;
            PG8_LDA(At, 0, 1); PG8_STAGE(PG8_SA(0, 0), a2, voffA);
            PG8_BAR; PG8_WAIT_L(0); PG8_MMA(1, 0, At, B0); PG8_BAR; PG8_SCHED;
            PG8_STAGE(PG8_SB(0, 1), b2 + hstep, voffB);
            PG8_WAIT_V(6); PG8_BAR; PG8_MMA(1, 1, At, B1); PG8_BAR;
            PG8_LDB(B0, 1, 0); PG8_SCHED; PG8_LDA(At, 1, 0); PG8_STAGE(PG8_SA(0, 1), a2 + hstep, voffA);
            PG8_WAIT_L(8); PG8_BAR; PG8_WAIT_L(0); PG8_MMA(0, 0, At, B0); PG8_BAR; PG8_SCHED;
            PG8_LDB(B1, 1, 1); PG8_STAGE(PG8_SB(1, 0), b3, voffB);
            PG8_BAR; PG8_WAIT_L(0); PG8_MMA(0, 1, At, B1); PG8_BAR;
            PG8_LDA(At, 1, 1); PG8_STAGE(PG8_SA(1, 0), a3, voffA);
            PG8_BAR; PG8_WAIT_L(0); PG8_MMA(1, 0, At, B0); PG8_BAR; PG8_SCHED;
            PG8_STAGE(PG8_SB(1, 1), b3 + hstep, voffB);
            PG8_WAIT_V(6); PG8_BAR; PG8_MMA(1, 1, At, B1); PG8_BAR;
            }
        }
        if constexpr (ALIGN_EPI) { if (wr == 0) PG8_BAR; }
        bool keep = false;
        if constexpr (Epi::CHAIN) { keep = (cur.sel == 0); if (keep) E.mid(acc, cur, wr, wc, fr, fq); else E(acc, cur, wr, wc, fr, fq); }
        else if constexpr (!Epi::AFTER_DRAIN) { E(acc, cur, wr, wc, fr, fq); S.done(cur); }
        if (!has_next) break;
        if (!keep) {
#pragma unroll
        for (int a = 0; a < 2; ++a)
#pragma unroll
            for (int b = 0; b < 2; ++b)
#pragma unroll
                for (int m = 0; m < 4; ++m)
#pragma unroll
                    for (int n = 0; n < 2; ++n) acc[a][b][m][n] = (f32x4){0.f, 0.f, 0.f, 0.f};
        }
        cur = nxt; cA = nA; cB = nB; ++ui;
        if constexpr (ALIGN_EPI) { if (wr == 1) PG8_BAR; }
    }
    PG8_WAIT_V(0);
    if constexpr (!ALIGN_EPI) { if (wr == 0) PG8_BAR; }
    PG8_BAR;
    if constexpr (Epi::AFTER_DRAIN) { E.fused(acc, cur, wr, wc, fr, fq, lds, wid, lane); S.done(cur); }
#undef PG8_SA
#undef PG8_SB
#undef PG8_STAGE
#undef PG8_LDA
#undef PG8_LDB
#undef PG8_MMA
#undef PG8_WAIT_V
#undef PG8_WAIT_L
#undef PG8_BAR
#undef PG8_SCHED
}
}

#define LAS __attribute__((address_space(3)))
typedef unsigned short bf16;
typedef unsigned v4u __attribute__((ext_vector_type(4)));
typedef unsigned v2u __attribute__((ext_vector_type(2)));
typedef float f32x4 __attribute__((ext_vector_type(4)));
typedef short bf16x8 __attribute__((ext_vector_type(8)));

constexpr int NB = 8, SEQ = 2048, D = 1024, T = NB * SEQ;
constexpr int AW = 512, NG = 8, GD = 64, CHUNK = 128;
constexpr int BW = 512, FF = 4096;
constexpr int INC = 4608;
constexpr int FH = 64, FE = 33;
constexpr float EPS = 1e-6f;
constexpr int NWAVES = 8, NTHR = 512;
constexpr int LDS_BYTES = 147456;

constexpr size_t MiB = 1u << 20;
constexpr size_t WS_CTL = 0;
constexpr size_t WS_H2 = 1 * MiB;
constexpr size_t WS_SSP = WS_H2 + 512 * 1024;
constexpr size_t WS_WSB = WS_SSP + 256 * 1024;
constexpr size_t WS_WAG = 2 * MiB;
constexpr size_t WS_WPB = 8 * MiB;
constexpr size_t WS_WA = 12 * MiB, WS_WB = 13 * MiB, WS_WO = 14 * MiB, WS_W1 = 16 * MiB, WS_W2 = 24 * MiB;
constexpr size_t WS_XN = 32 * MiB;
constexpr size_t WS_ZA = 64 * MiB;
constexpr size_t WS_YBT = 64 * MiB;
constexpr size_t WS_MIX = 64 * MiB;
constexpr size_t WS_F1 = 64 * MiB;
constexpr size_t WS_PBT = 96 * MiB;
constexpr size_t WS_GATES = 144 * MiB;
constexpr size_t WS_YA = 208 * MiB;
constexpr size_t WS_YB = 224 * MiB;
constexpr size_t WS_Z1T = 240 * MiB;
constexpr size_t WS_F = 192 * MiB;
constexpr size_t WS_END = 256 * MiB;

__device__ __forceinline__ unsigned f2bf(float f) { unsigned u = __builtin_bit_cast(unsigned, f); return (u + 0x7fffu + ((u >> 16) & 1u)) >> 16; }
__device__ __forceinline__ unsigned pk2(float lo, float hi) { return f2bf(lo) | (f2bf(hi) << 16); }
__device__ __forceinline__ float bf2f(unsigned short b) { return __builtin_bit_cast(float, (unsigned)b << 16); }
__device__ __forceinline__ float bflo(unsigned w) { return __builtin_bit_cast(float, w << 16); }
__device__ __forceinline__ float bfhi(unsigned w) { return __builtin_bit_cast(float, w & 0xffff0000u); }
__device__ __forceinline__ float wave_sum(float v) {
#pragma unroll
    for (int o = 1; o < 64; o <<= 1) v += __shfl_xor(v, o);
    return v;
}
#define LDS_WAIT() asm volatile("s_waitcnt lgkmcnt(0)" ::: "memory")

namespace pg8 {
struct EpiInA {
    static constexpr bool PERM = true, AFTER_DRAIN = false, CHAIN = false;
    bf16_t* ZA; bf16_t* GT;
    __device__ __forceinline__ void operator()(const f32x4 (&acc)[2][2][4][2], const Unit& u, int wr, int wc, int fr, int fq) const {
        const int row0 = u.pm * BM + wr * 64 + fr; const bool isg = u.pn >= 4;
        bf16_t* base = isg ? GT : ZA; const int ldc = isg ? 2048 : 1024; const int col0 = (isg ? (u.pn - 4) : u.pn) * BM + wc * 32 + 8 * fq;
#pragma unroll
        for (int ai = 0; ai < 2; ++ai)
#pragma unroll
            for (int m = 0; m < 4; ++m) { bf16_t* rowp = base + (size_t)(row0 + ai * HALF + m * 16) * ldc + col0;
#pragma unroll
                for (int bj = 0; bj < 2; ++bj) { float v[8];
#pragma unroll
                    for (int j = 0; j < 4; ++j) { v[j] = acc[ai][bj][m][0][j]; v[4 + j] = acc[ai][bj][m][1][j]; }
#pragma unroll
                    for (int j = 0; j < 8; ++j) { const float x = v[j];
                        const float arg = isg ? x : 1.5957691216057308f * (x + 0.044715f * x * x * x);
                        const float sg = __builtin_amdgcn_rcpf(1.0f + __builtin_amdgcn_exp2f(-1.4426950408889634f * arg));
                        v[j] = isg ? sg : x * sg; }
                    u32x4 w; w.x = cvt_pk_bf16(v[0], v[1]); w.y = cvt_pk_bf16(v[2], v[3]); w.z = cvt_pk_bf16(v[4], v[5]); w.w = cvt_pk_bf16(v[6], v[7]);
                    *(u32x4*)(rowp + bj * HALF) = w; } }
    }
};
template <int ACT> struct EpiBf {
    static constexpr bool PERM = true, AFTER_DRAIN = false, CHAIN = false;
    bf16_t* O; int ldc;
    __device__ __forceinline__ void operator()(const f32x4 (&acc)[2][2][4][2], const Unit& u, int wr, int wc, int fr, int fq) const {
        const int row0 = u.pm * BM + wr * 64 + fr; const int col0 = u.pn * BM + wc * 32 + 8 * fq;
#pragma unroll
        for (int ai = 0; ai < 2; ++ai)
#pragma unroll
            for (int m = 0; m < 4; ++m) { bf16_t* rowp = O + (size_t)(row0 + ai * HALF + m * 16) * ldc + col0;
#pragma unroll
                for (int bj = 0; bj < 2; ++bj) { f32x4 v0 = acc[ai][bj][m][0], v1 = acc[ai][bj][m][1];
                    if (ACT == 1) {
#pragma unroll
                        for (int j = 0; j < 4; ++j) { const float a = fmaxf(v0[j], 0.f), b = fmaxf(v1[j], 0.f); v0[j] = a * a; v1[j] = b * b; } }
                    u32x4 w; w.x = cvt_pk_bf16(v0[0], v0[1]); w.y = cvt_pk_bf16(v0[2], v0[3]); w.z = cvt_pk_bf16(v1[0], v1[1]); w.w = cvt_pk_bf16(v1[2], v1[3]);
                    *(u32x4*)(rowp + bj * HALF) = w; } }
    }
};
struct EpiMix {
    static constexpr bool PERM = true, AFTER_DRAIN = false, CHAIN = true;
    const bf16_t* GT; bf16_t* MIX;
    __device__ __forceinline__ void mid(f32x4 (&acc)[2][2][4][2], const Unit& u, int wr, int wc, int fr, int fq) const {
        const int row0 = u.pm * BM + wr * 64 + fr; const int col0 = u.pn * BM + wc * 32 + 8 * fq;
#pragma unroll
        for (int ai = 0; ai < 2; ++ai)
#pragma unroll
            for (int m = 0; m < 4; ++m) { const bf16_t* gp = GT + (size_t)(row0 + ai * HALF + m * 16) * 2048 + col0;
#pragma unroll
                for (int bj = 0; bj < 2; ++bj) { const u32x4 ga = *(const u32x4*)(gp + bj * HALF), gb = *(const u32x4*)(gp + 1024 + bj * HALF);
                    const unsigned gaw[4] = {ga.x, ga.y, ga.z, ga.w}, gbw[4] = {gb.x, gb.y, gb.z, gb.w};
#pragma unroll
                    for (int j = 0; j < 4; ++j) { const int n = j >> 1, e = (j & 1) * 2;
                        const float r0 = __uint_as_float(gaw[j] << 16) / fmaxf(__uint_as_float(gbw[j] << 16), 1e-30f);
                        const float r1 = __uint_as_float(gaw[j] & 0xffff0000u) / fmaxf(__uint_as_float(gbw[j] & 0xffff0000u), 1e-30f);
                        acc[ai][bj][m][n][e] *= r0; acc[ai][bj][m][n][e + 1] *= r1; } } }
    }
    __device__ __forceinline__ void operator()(const f32x4 (&acc)[2][2][4][2], const Unit& u, int wr, int wc, int fr, int fq) const {
        const int row0 = u.pm * BM + wr * 64 + fr; const int col0 = u.pn * BM + wc * 32 + 8 * fq;
#pragma unroll
        for (int ai = 0; ai < 2; ++ai)
#pragma unroll
            for (int m = 0; m < 4; ++m) { const size_t r = (size_t)(row0 + ai * HALF + m * 16); const bf16_t* gp = GT + r * 2048 + 1024 + col0; bf16_t* op = MIX + r * 1024 + col0;
#pragma unroll
                for (int bj = 0; bj < 2; ++bj) { const u32x4 gb = *(const u32x4*)(gp + bj * HALF); const unsigned gbw[4] = {gb.x, gb.y, gb.z, gb.w}; unsigned ow[4];
#pragma unroll
                    for (int j = 0; j < 4; ++j) { const int n = j >> 1, e = (j & 1) * 2;
                        const float g0 = fmaxf(__uint_as_float(gbw[j] << 16), 1e-30f), g1 = fmaxf(__uint_as_float(gbw[j] & 0xffff0000u), 1e-30f);
                        ow[j] = cvt_pk_bf16(acc[ai][bj][m][n][e] * g0, acc[ai][bj][m][n][e + 1] * g1); }
                    u32x4 w; w.x = ow[0]; w.y = ow[1]; w.z = ow[2]; w.w = ow[3];
                    *(u32x4*)(op + bj * HALF) = w; } }
    }
};
struct EpiF32 {
    static constexpr bool PERM = false, AFTER_DRAIN = false, CHAIN = false;
    float* C; int ldc;
    __device__ __forceinline__ void operator()(const f32x4 (&acc)[2][2][4][2], const Unit& u, int wr, int wc, int fr, int fq) const {
        const int row0 = u.pm * BM + wr * 64 + fr, col0 = u.pn * BM + wc * 32 + 4 * fq;
#pragma unroll
        for (int ai = 0; ai < 2; ++ai)
#pragma unroll
            for (int m = 0; m < 4; ++m) { float* rowp = C + (size_t)(row0 + ai * HALF + m * 16) * ldc + col0;
#pragma unroll
                for (int bj = 0; bj < 2; ++bj)
#pragma unroll
                    for (int n = 0; n < 2; ++n) *(f32x4*)(rowp + bj * HALF + n * 16) = acc[ai][bj][m][n]; }
    }
};
}

struct Args { const float* in[24]; float* out; unsigned char* ws; };
struct Frame {
    LAS unsigned char* lds;
    int tid, lane, wave, G, bid;
};

__device__ __forceinline__ void p0_transpose_item(const float* W, int K, int N, bf16* WT, bf16* WT2, int mode, LAS float* scr, int item, int lane) {
    const int nblk = N / 32, kb = item / nblk, nb = item % nblk, k0 = 64 * kb, n0 = 32 * nb;
#pragma unroll 8
    for (int i = 0; i < 32; ++i) { const int kk = 2 * i + (lane >> 5); scr[kk * 33 + (lane & 31)] = W[(size_t)(k0 + kk) * N + n0 + (lane & 31)]; }
    LDS_WAIT(); asm volatile("" ::: "memory");
    bf16* dst = WT; int r0 = n0;
    if (mode == 1) { if (n0 < 1024) { r0 = n0; } else if (n0 < 2560) { dst = WT2; r0 = n0 - 1024; } else { r0 = n0 - 2560 + 1024; } }
    const int c = lane & 7;
#pragma unroll
    for (int j = 0; j < 4; ++j) { const int n = (lane >> 3) + 8 * j; const LAS float* s = scr + (8 * c) * 33 + n;
        v4u o; o.x = pk2(s[0 * 33], s[1 * 33]); o.y = pk2(s[2 * 33], s[3 * 33]); o.z = pk2(s[4 * 33], s[5 * 33]); o.w = pk2(s[6 * 33], s[7 * 33]);
        *(v4u*)(dst + (size_t)(r0 + n) * K + k0 + 8 * c) = o; }
    LDS_WAIT(); asm volatile("" ::: "memory");
}
__device__ __forceinline__ void rms_row_to_bf16(const float* xrow, const float* g, bf16* orow, int lane) {
    const f32x4* xr = (const f32x4*)xrow + lane; const f32x4* gr = (const f32x4*)g + lane;
    f32x4 v[4]; float s = 0.f;
#pragma unroll
    for (int j = 0; j < 4; ++j) { v[j] = xr[64 * j]; s += (v[j].x * v[j].x + v[j].y * v[j].y) + (v[j].z * v[j].z + v[j].w * v[j].w); }
    const float r = 1.0f / sqrtf(wave_sum(s) * (1.f / D) + EPS);
    unsigned long long* o8 = (unsigned long long*)orow + lane;
#pragma unroll
    for (int j = 0; j < 4; ++j) { const f32x4 gg = gr[64 * j]; o8[64 * j] = (unsigned long long)pk2(v[j].x * r * gg.x, v[j].y * r * gg.y) | ((unsigned long long)pk2(v[j].z * r * gg.z, v[j].w * r * gg.w) << 32); }
}
__device__ __forceinline__ void filt_hidden(const Args& a, int l, int lane, float* H2) {
    const float* w1 = a.in[9]; const float* b1 = a.in[10]; const float* f1 = a.in[11]; const float* w2 = a.in[12]; const float* b2 = a.in[13]; const float* f2 = a.in[14];
    const float tpos = (float)l / (float)(SEQ - 1);
    const float w = 6.283185307179586f * (float)l / (float)SEQ;
    float feat = 0.f;
    if (lane == 0) feat = tpos;
    else if (lane < 33) { const int k = (lane - 1) & 15; const float fr = 1e-4f + (float)k * ((15.0f - 1e-4f) / 15.0f); const float ang = fr * w; feat = (lane <= 16) ? cosf(ang) : -sinf(ang); }
    float pre = b1[lane];
    for (int i = 0; i < FE; ++i) pre += __shfl(feat, i) * w1[i * FH + lane];
    const float h1 = sinf(f1[lane] * pre);
    float pre2 = b2[lane];
    for (int i = 0; i < FH; ++i) pre2 += __shfl(h1, i) * w2[i * FH + lane];
    H2[l * FH + lane] = sinf(f2[lane] * pre2);
}
__device__ __forceinline__ void p0_prologue(const Args& a, Frame& F) {
    LAS float* scr = (LAS float*)(F.lds + F.wave * 16384);
    const int gw = F.bid * NWAVES + F.wave, NGW = F.G * NWAVES;
    unsigned char* ws = a.ws;
    constexpr int I_IN = (D / 64) * (INC / 32), I_A = (AW / 64) * (D / 32), I_B = I_A, I_O = (D / 64) * (D / 32), I_1 = (D / 64) * (FF / 32), I_2 = (FF / 64) * (D / 32);
    constexpr int NITEMS = I_IN + I_A + I_B + I_O + I_1 + I_2;
    for (int it = gw; it < NITEMS; it += NGW) {
        int r = it;
        if (r < I_IN) { p0_transpose_item(a.in[2], D, INC, (bf16*)(ws + WS_WAG), (bf16*)(ws + WS_WPB), 1, scr, r, F.lane); continue; } r -= I_IN;
        if (r < I_A) { p0_transpose_item(a.in[6], AW, D, (bf16*)(ws + WS_WA), nullptr, 0, scr, r, F.lane); continue; } r -= I_A;
        if (r < I_B) { p0_transpose_item(a.in[17], BW, D, (bf16*)(ws + WS_WB), nullptr, 0, scr, r, F.lane); continue; } r -= I_B;
        if (r < I_O) { p0_transpose_item(a.in[18], D, D, (bf16*)(ws + WS_WO), nullptr, 0, scr, r, F.lane); continue; } r -= I_O;
        if (r < I_1) { p0_transpose_item(a.in[21], D, FF, (bf16*)(ws + WS_W1), nullptr, 0, scr, r, F.lane); continue; } r -= I_1;
        p0_transpose_item(a.in[22], FF, D, (bf16*)(ws + WS_W2), nullptr, 0, scr, r, F.lane);
    }
    for (int m = gw; m < T; m += NGW) rms_row_to_bf16(a.in[0] + (size_t)m * D, a.in[1], (bf16*)(ws + WS_XN) + (size_t)m * D, F.lane);
    for (int l = gw; l < SEQ; l += NGW) filt_hidden(a, l, F.lane, (float*)(ws + WS_H2));
    { const float* wsf = a.in[4]; bf16* wsb = (bf16*)(ws + WS_WSB); const int gt = F.bid * NTHR + F.tid;
      for (int i = gt; i < NG * CHUNK * CHUNK / 4; i += F.G * NTHR) { const f32x4 v = ((const f32x4*)wsf)[i]; v2u o; o.x = pk2(v.x, v.y); o.y = pk2(v.z, v.w); ((v2u*)wsb)[i] = o; } }
}

__device__ __forceinline__ void filt_raw_item(const Args& a, int item, int lane, const float* H2, float* HF, float* SSP) {
    const int lb = item >> 7, cb = item & 127; const int l = lb * 64 + lane;
    const float* w3 = a.in[15];
    f32x4 h[16];
#pragma unroll
    for (int j = 0; j < 16; ++j) h[j] = ((const f32x4*)(H2 + (size_t)l * FH))[j];
    const float tpos = (float)l / (float)(SEQ - 1);
    const float min_decay = -3.0701134573253945f, max_decay = -15.350567286626973f;
    for (int cc = 0; cc < 16; ++cc) {
        const int col = cb * 16 + cc; float acc = 0.f;
#pragma unroll
        for (int j = 0; j < 16; ++j) { acc += h[j].x * w3[(4 * j + 0) * 2048 + col]; acc += h[j].y * w3[(4 * j + 1) * 2048 + col]; acc += h[j].z * w3[(4 * j + 2) * 2048 + col]; acc += h[j].w * w3[(4 * j + 3) * 2048 + col]; }
        const int c = col & 511; const float delta = fabsf(min_decay + (float)c * ((max_decay - min_decay) / 511.0f));
        const float v = acc * (expf(-tpos * delta) + 0.05f);
        HF[(size_t)col * SEQ + l] = v;
        const float ss = wave_sum(v * v);
        if (lane == 0) SSP[lb * 2048 + col] = ss;
    }
}

constexpr int VN_STATS_OFF = 70144;
__device__ __forceinline__ int vn_off(int row, int tok) { return row * 272 + (row >> 3) * 16 + tok * 2; }
__device__ __forceinline__ void spatial_unit(const Args& a, Frame& F, int ua) {
    unsigned char* ws = a.ws;
    const bf16* ZA = (const bf16*)(ws + WS_ZA); bf16* YA = (bf16*)(ws + WS_YA); const bf16* WSB = (const bf16*)(ws + WS_WSB);
    const float* vgain = a.in[3]; const float* bs = a.in[5];
    const int bc = ua >> 1, half = ua & 1, t0 = bc * CHUNK;
    LAS float* stats = (LAS float*)(F.lds + VN_STATS_OFF);
    for (int i = 0; i < 16; ++i) { const int tok = F.wave * 16 + i;
        const v4u raw = *(const v4u*)(ZA + (size_t)(t0 + tok) * 1024 + 512 + F.lane * 8);
        float x[8] = {bflo(raw.x), bfhi(raw.x), bflo(raw.y), bfhi(raw.y), bflo(raw.z), bfhi(raw.z), bflo(raw.w), bfhi(raw.w)};
        float s = 0.f;
#pragma unroll
        for (int j = 0; j < 8; ++j) s += x[j];
        const float mean = wave_sum(s) * (1.f / 512.f); float q = 0.f;
#pragma unroll
        for (int j = 0; j < 8; ++j) { const float d = x[j] - mean; q += d * d; }
        const float rstd = 1.0f / sqrtf(wave_sum(q) * (1.f / 512.f) + EPS);
        if (F.lane == 0) { stats[2 * tok] = mean; stats[2 * tok + 1] = rstd; } }
    __syncthreads();
    for (int it = 0; it < 8; ++it) {
        const int task = it * NTHR + F.tid;
        const int ch8 = (task & 7) + ((task >> 6) & 3) * 8, tok = ((task >> 3) & 7) + (task >> 8) * 8;
        const int ch = ch8 * 8;
        const v4u raw = *(const v4u*)(ZA + (size_t)(t0 + tok) * 1024 + 512 + half * 256 + ch);
        const float mean = stats[2 * tok], rstd = stats[2 * tok + 1];
        const float* gp = vgain + half * 256 + ch;
        float x[8] = {bflo(raw.x), bfhi(raw.x), bflo(raw.y), bfhi(raw.y), bflo(raw.z), bfhi(raw.z), bflo(raw.w), bfhi(raw.w)};
#pragma unroll
        for (int j = 0; j < 8; ++j) { const float v = (x[j] - mean) * rstd * gp[j]; *(LAS unsigned short*)(F.lds + vn_off(ch + j, tok)) = (unsigned short)f2bf(v); }
    }
    __syncthreads();
    const int fr = F.lane & 15, fq = F.lane >> 4;
    const int tl = F.wave * 16 + fr;
    for (int gl = 0; gl < 4; ++gl) { const int g = half * 4 + gl;
        bf16x8 Y[4];
#pragma unroll
        for (int ks = 0; ks < 4; ++ks) Y[ks] = *(const bf16x8*)(WSB + ((size_t)g * CHUNK + tl) * CHUNK + ks * 32 + fq * 8);
        const float bsv = bs[g * CHUNK + tl];
#pragma unroll
        for (int dt = 0; dt < 4; ++dt) { f32x4 acc = {0.f, 0.f, 0.f, 0.f};
#pragma unroll
            for (int ks = 0; ks < 4; ++ks) { const bf16x8 X = *(const LAS bf16x8*)(F.lds + vn_off(gl * 64 + dt * 16 + fr, ks * 32 + fq * 8));
                acc = __builtin_amdgcn_mfma_f32_16x16x32_bf16(X, Y[ks], acc, 0, 0, 0); }
            const int chn = half * 256 + gl * 64 + dt * 16 + fq * 4;
            const v2u uraw = *(const v2u*)(ZA + (size_t)(t0 + tl) * 1024 + chn);
            v2u o; o.x = pk2(bflo(uraw.x) * (acc[0] + bsv), bfhi(uraw.x) * (acc[1] + bsv)); o.y = pk2(bflo(uraw.y) * (acc[2] + bsv), bfhi(uraw.y) * (acc[3] + bsv));
            *(v2u*)(YA + (size_t)(t0 + tl) * 512 + chn) = o; } }
    __syncthreads();
}

constexpr int FC_STRIDE = 8480, ZB_OFF = 8 * FC_STRIDE, ZB_STRIDE = 5136;
template <int ORD>
__device__ __forceinline__ void conv_unit(const Args& a, Frame& F, int c) {
    unsigned char* ws = a.ws;
    const bf16* PBT = (const bf16*)(ws + WS_PBT);
    const float* HF = a.out; const float* SSP = (const float*)(ws + WS_SSP);
    const float* cw = a.in[7]; const float* cb = a.in[8];
    const int tid = F.tid, lane = F.lane, w = F.wave;
    float ssum = 0.f;
    if (lane < 32) ssum = SSP[lane * 2048 + (ORD * 2 + 0) * 512 + c] + SSP[lane * 2048 + (ORD * 2 + 1) * 512 + c];
    const float fscale = 1.0f / sqrtf(wave_sum(ssum) + EPS);
    const float* hfw = HF + (size_t)((ORD * 2 + 0) * 512 + c) * SEQ; const float* hbw = HF + (size_t)((ORD * 2 + 1) * 512 + c) * SEQ;
    for (int p = tid; p < 4232; p += NTHR) {
        const int gi = 2048 - p; float v = 0.f;
        if (gi >= -2047 && gi <= 2047) { v = gi > 0 ? hfw[gi] : (gi < 0 ? hbw[-gi] : hfw[0] + hbw[0]); v *= fscale; }
        const unsigned short hv = (unsigned short)f2bf(v);
#pragma unroll
        for (int r = 0; r < 8; ++r) *(LAS unsigned short*)(F.lds + r * FC_STRIDE + (p + r) * 2) = hv;
    }
    if (tid < 8) {
        for (int x = 0; x < tid; ++x) *(LAS unsigned short*)(F.lds + tid * FC_STRIDE + x * 2) = 0; }
    const bf16* zsrc = (ORD == 0) ? PBT + (size_t)(1024 + c) * T : (const bf16*)(ws + WS_Z1T) + (size_t)c * T;
    const float w0 = cw[0 * 1536 + 1024 + c], w1 = cw[1 * 1536 + 1024 + c], w2 = cw[2 * 1536 + 1024 + c], wb = cb[1024 + c];
    for (int i = tid; i < 8 * 64; i += NTHR) { const int b = i >> 6, k = i & 63; const int tt = (k < 32) ? k * 8 : 2304 + (k - 32) * 8;
        *(LAS v4u*)(F.lds + ZB_OFF + b * ZB_STRIDE + tt * 2) = (v4u){0u, 0u, 0u, 0u}; }
    for (int i = tid; i < T / 8; i += NTHR) { const int b = i >> 8, t0 = (i & 255) * 8;
        const v4u raw = *(const v4u*)(zsrc + (size_t)b * SEQ + t0);
        v4u o = raw;
        if (ORD == 0) {
            float x[10]; x[1] = bflo(raw.x); x[2] = bfhi(raw.x); x[3] = bflo(raw.y); x[4] = bfhi(raw.y); x[5] = bflo(raw.z); x[6] = bfhi(raw.z); x[7] = bflo(raw.w); x[8] = bfhi(raw.w);
            x[0] = t0 > 0 ? bf2f(zsrc[(size_t)b * SEQ + t0 - 1]) : 0.f; x[9] = t0 + 8 < SEQ ? bf2f(zsrc[(size_t)b * SEQ + t0 + 8]) : 0.f;
            float y[8];
#pragma unroll
            for (int j = 0; j < 8; ++j) y[j] = w0 * x[j] + w1 * x[j + 1] + w2 * x[j + 2] + wb;
            o.x = pk2(y[0], y[1]); o.y = pk2(y[2], y[3]); o.z = pk2(y[4], y[5]); o.w = pk2(y[6], y[7]);
        }
        *(LAS v4u*)(F.lds + ZB_OFF + b * ZB_STRIDE + (t0 + 256) * 2) = o; }
    __syncthreads();
    const int fr = lane & 15, fq = lane >> 4;
    const int batch = fr & 7, il = fr >> 3;
    const int abase = (fr & 7) * FC_STRIDE + 2 * (2048 - 16 * (16 * w - 128 + (fq >> 1)) - 8 * (fr >> 3) + 8 * (fq & 1));
    const int bbase = ZB_OFF + batch * ZB_STRIDE + 2 * (16 * (128 + il - (fq >> 1)) + 8 * (fq & 1) + 256);
    f32x4 acc[8];
#pragma unroll
    for (int i = 0; i < 8; ++i) acc[i] = (f32x4){0.f, 0.f, 0.f, 0.f};
    bf16x8 R[8];
#pragma unroll
    for (int m = 1; m < 8; ++m) R[m] = *(const LAS bf16x8*)(F.lds + bbase + 64 * m);
    for (int s8 = 0; s8 < 72; s8 += 8) {
#pragma unroll
        for (int ss = 0; ss < 8; ++ss) { const int s = s8 + ss;
            R[(8 - ss) & 7] = *(const LAS bf16x8*)(F.lds + bbase - 64 * s);
            const bf16x8 Af = *(const LAS bf16x8*)(F.lds + abase - 64 * s);
#pragma unroll
            for (int tau = 0; tau < 8; ++tau) acc[tau] = __builtin_amdgcn_mfma_f32_16x16x32_bf16(Af, R[(tau - ss + 8) & 7], acc[tau], 0, 0, 0);
        }
    }
    const float skip = a.in[16][ORD * 512 + c];
    const int gch = (ORD == 0) ? c : 512 + c;
    const bf16* gsrc = PBT + (size_t)gch * T + (size_t)batch * SEQ;
    const float g0 = cw[0 * 1536 + gch], g1 = cw[1 * 1536 + gch], g2 = cw[2 * 1536 + gch], gb = cb[gch];
    bf16* dst = ((ORD == 0) ? (bf16*)(ws + WS_Z1T) : (bf16*)(ws + WS_YBT)) + (size_t)c * T + (size_t)batch * SEQ;
#pragma unroll
    for (int tau = 0; tau < 8; ++tau) { const int t = 16 * (16 * w + 2 * tau + il) + 4 * fq;
        const v2u zr = *(const LAS v2u*)(F.lds + ZB_OFF + batch * ZB_STRIDE + (t + 256) * 2);
        const v2u gr = *(const v2u*)(gsrc + t);
        float x[6]; x[1] = bflo(gr.x); x[2] = bfhi(gr.x); x[3] = bflo(gr.y); x[4] = bfhi(gr.y);
        x[0] = t > 0 ? bf2f(gsrc[t - 1]) : 0.f; x[5] = t + 4 < SEQ ? bf2f(gsrc[t + 4]) : 0.f;
        const float z4[4] = {bflo(zr.x), bfhi(zr.x), bflo(zr.y), bfhi(zr.y)}; float y[4];
#pragma unroll
        for (int r = 0; r < 4; ++r) { const float gate = g0 * x[r] + g1 * x[r + 1] + g2 * x[r + 2] + gb; y[r] = gate * (acc[tau][r] + skip * z4[r]); }
        v2u o; o.x = pk2(y[0], y[1]); o.y = pk2(y[2], y[3]);
        *(v2u*)(dst + t) = o; }
    __syncthreads();
}

__device__ __forceinline__ void transpose_item(const Args& a, Frame& F, int item) {
    const bf16* src = (const bf16*)(a.ws + WS_YBT); bf16* dst = (bf16*)(a.ws + WS_YB);
    LAS unsigned short* tile = (LAS unsigned short*)(F.lds + F.wave * 16384);
    const int cblk = item & 7, tblk = item >> 3, c0 = cblk * 64, t0 = tblk * 64, lane = F.lane;
#pragma unroll
    for (int it = 0; it < 16; ++it) { const int ch = it * 4 + (lane >> 4), tk = (lane & 15) * 4;
        const v2u v = *(const v2u*)(src + (size_t)(c0 + ch) * T + t0 + tk);
        *(LAS v2u*)(tile + ch * 68 + tk) = v; }
    LDS_WAIT(); asm volatile("" ::: "memory");
#pragma unroll
    for (int it = 0; it < 8; ++it) { const int tok = it * 8 + (lane >> 3), c8 = (lane & 7) * 8; unsigned short e[8];
#pragma unroll
        for (int k = 0; k < 8; ++k) e[k] = tile[(c8 + k) * 68 + tok];
        v4u o; o.x = e[0] | ((unsigned)e[1] << 16); o.y = e[2] | ((unsigned)e[3] << 16); o.z = e[4] | ((unsigned)e[5] << 16); o.w = e[6] | ((unsigned)e[7] << 16);
        *(v4u*)(dst + (size_t)(t0 + tok) * 512 + c0 + c8) = o; }
    LDS_WAIT(); asm volatile("" ::: "memory");
}

__device__ __forceinline__ void post_mix_row(const Args& a, int row, int lane) {
    float* mrow = a.out + (size_t)row * D; const float* xrow = a.in[0] + (size_t)row * D; bf16* hn = (bf16*)(a.ws + WS_XN) + (size_t)row * D;
    const f32x4* g1 = (const f32x4*)a.in[19] + lane; const f32x4* g2 = (const f32x4*)a.in[20] + lane;
    f32x4 m[4], h[4]; float s = 0.f;
#pragma unroll
    for (int j = 0; j < 4; ++j) { m[j] = ((const f32x4*)mrow + lane)[64 * j]; s += (m[j].x * m[j].x + m[j].y * m[j].y) + (m[j].z * m[j].z + m[j].w * m[j].w); }
    const float r1 = 1.0f / sqrtf(wave_sum(s) * (1.f / D) + EPS); float s2 = 0.f;
#pragma unroll
    for (int j = 0; j < 4; ++j) { const f32x4 x = ((const f32x4*)xrow + lane)[64 * j]; h[j] = x + m[j] * r1 * g1[64 * j]; s2 += (h[j].x * h[j].x + h[j].y * h[j].y) + (h[j].z * h[j].z + h[j].w * h[j].w); }
    const float r2 = 1.0f / sqrtf(wave_sum(s2) * (1.f / D) + EPS);
#pragma unroll
    for (int j = 0; j < 4; ++j) { ((f32x4*)mrow + lane)[64 * j] = h[j]; const f32x4 gg = g2[64 * j];
        ((unsigned long long*)hn + lane)[64 * j] = (unsigned long long)pk2(h[j].x * r2 * gg.x, h[j].y * r2 * gg.y) | ((unsigned long long)pk2(h[j].z * r2 * gg.z, h[j].w * r2 * gg.w) << 32); }
}
__device__ __forceinline__ void post_ffn_row(const Args& a, int row, int lane) {
    float* hrow = a.out + (size_t)row * D; const float* frow = (const float*)(a.ws + WS_F) + (size_t)row * D;
    const f32x4* g3 = (const f32x4*)a.in[23] + lane;
    f32x4 f[4]; float s = 0.f;
#pragma unroll
    for (int j = 0; j < 4; ++j) { f[j] = ((const f32x4*)frow + lane)[64 * j]; s += (f[j].x * f[j].x + f[j].y * f[j].y) + (f[j].z * f[j].z + f[j].w * f[j].w); }
    const float r = 1.0f / sqrtf(wave_sum(s) * (1.f / D) + EPS);
#pragma unroll
    for (int j = 0; j < 4; ++j) { const f32x4 h = ((const f32x4*)hrow + lane)[64 * j]; ((f32x4*)hrow + lane)[64 * j] = h + f[j] * r * g3[64 * j]; }
}

typedef __attribute__((address_space(1))) unsigned gu32;
#define RLX_AGENT __ATOMIC_RELAXED, __HIP_MEMORY_SCOPE_AGENT
#define XB_TMO      128
#define XB_XCNT(j)  (256  + 64 * (j))
#define XB_XSUB(j)  (1280 + 64 * (j))
#define XB_XGEN(j)  (2304 + 64 * (j))
#define XB_TOP      3328
#define XB_TOPGEN   3392
#define XCD_BAR_WORDS 3456
#define XB_SPIN_CAP (1u << 18)

__device__ __forceinline__ unsigned xb_ld(unsigned* p)              { return __hip_atomic_load(p, __ATOMIC_RELAXED, __HIP_MEMORY_SCOPE_AGENT); }
__device__ __forceinline__ unsigned xb_add(unsigned* p, unsigned v) { return __hip_atomic_fetch_add(p, v, __ATOMIC_RELAXED, __HIP_MEMORY_SCOPE_AGENT); }
__device__ __forceinline__ unsigned xb_xcc_id() { return (unsigned)__builtin_amdgcn_s_getreg((3 << 11) | 20) & 0xFu; }
#define XB_SPIN(cond, bar) do { unsigned _sp = 0; while (cond) { __builtin_amdgcn_s_sleep(1); \
    if ((++_sp & 255u) == 0u) { if (xb_ld(&(bar)[XB_TMO])) break; if (_sp > XB_SPIN_CAP) { atomicAdd(&(bar)[XB_TMO], 1u); break; } } } } while (0)

struct XcdBarrier {
    unsigned* bar; unsigned x;
    volatile LAS unsigned* st;
};

__device__ __forceinline__ XcdBarrier xcd_barrier_post(unsigned* bar, volatile LAS unsigned* st) {
    XcdBarrier b; b.bar = bar; b.x = xb_xcc_id(); b.st = st;
    if (threadIdx.x == 0) (void)xb_add(&bar[XB_XCNT(b.x)], 1u);
    return b;
}
__device__ __forceinline__ void xcd_barrier_complete(unsigned* bar, unsigned x, unsigned& nloc, unsigned& nx) {
    const unsigned G = gridDim.x * gridDim.y * gridDim.z;
    unsigned sum, cnt, mine, sp = 0u;
    for (;;) {
        sum = 0u; cnt = 0u; mine = 0u;
#pragma unroll
        for (unsigned j = 0; j < 16; ++j) { const unsigned c = xb_ld(&bar[XB_XCNT(j)]); sum += c; cnt += (c > 0u) ? 1u : 0u; mine = (j == x) ? c : mine; }
        if (sum == G) break;
        __builtin_amdgcn_s_sleep(1);
        if ((++sp & 255u) == 0u) { if (xb_ld(&bar[XB_TMO])) break; if (sp > XB_SPIN_CAP) { atomicAdd(&bar[XB_TMO], 1u); break; } }
    }
    nloc = mine > 0u ? mine : 1u; nx = cnt > 0u ? cnt : 1u;
}

__device__ __forceinline__ void xcd_barrier(const XcdBarrier& b) {
    asm volatile("s_waitcnt vmcnt(0)" ::: "memory");
    __syncthreads();
    if (threadIdx.x == 0) {
        unsigned* bar = b.bar;
        __builtin_amdgcn_s_waitcnt(0);
        unsigned nloc = b.st[0], nx = b.st[1];
        if (nloc == 0u) { xcd_barrier_complete(bar, b.x, nloc, nx); b.st[0] = nloc; b.st[1] = nx; }
        const unsigned old = xb_add(&bar[XB_XSUB(b.x)], 1u);
        const unsigned gen = old / nloc;
        if (old + 1u == (gen + 1u) * nloc) {
            __builtin_amdgcn_fence(__ATOMIC_RELEASE, "agent");
            asm volatile("s_waitcnt vmcnt(0)" ::: "memory");
            const unsigned og = xb_add(&bar[XB_TOP], 1u);
            const unsigned tg = og / nx;
            if (og + 1u == (tg + 1u) * nx) xb_add(&bar[XB_TOPGEN], 1u);
            else XB_SPIN(xb_ld(&bar[XB_TOPGEN]) == tg, bar);
            __builtin_amdgcn_fence(__ATOMIC_ACQUIRE, "agent");
            xb_add(&bar[XB_XGEN(b.x)], 1u);
            asm volatile("s_waitcnt vmcnt(0)" ::: "memory");
        } else {
            XB_SPIN(xb_ld(&bar[XB_XGEN(b.x)]) == gen, bar);
            __builtin_amdgcn_fence(__ATOMIC_ACQUIRE, "agent");
            asm volatile("s_waitcnt vmcnt(0)" ::: "memory");
        }
    }
    __syncthreads();
}

__global__ void __launch_bounds__(NTHR, 2) fwd_megakernel(Args args) {
    extern __shared__ __attribute__((aligned(16))) unsigned char lds_raw[];
    cg::grid_group grid = cg::this_grid();
    Frame F; F.lds = (LAS unsigned char*)lds_raw; F.tid = threadIdx.x; F.lane = F.tid & 63; F.wave = __builtin_amdgcn_readfirstlane(F.tid >> 6); F.G = gridDim.x; F.bid = blockIdx.x;
    unsigned char* ws = args.ws;
    const int gw = F.bid * NWAVES + F.wave, NGW = F.G * NWAVES;
    volatile LAS unsigned* MISC = (volatile LAS unsigned*)(F.lds + 131072);
    if (F.tid < 64) MISC[F.tid] = 0u;
    __syncthreads();
    XcdBarrier bar = xcd_barrier_post((unsigned*)(ws + WS_CTL) + 4096, MISC + 8);
#define GRID_BAR() xcd_barrier(bar)

    p0_prologue(args, F);
    grid.sync();
    {
        pg8::Gemm g{(const bf16*)(ws + WS_XN), (const bf16*)(ws + WS_WAG), nullptr, nullptr, T, 3072, D}; pg8::StaticOrder S; S.init(T, 3072, F.G, F.bid);
        pg8::EpiInA E{(bf16*)(ws + WS_ZA), (bf16*)(ws + WS_GATES)};
        pg8::gemm_phase<pg8::EpiInA, pg8::StaticOrder, true, true>(F.lds, g, S, E);
    }
    {
        pg8::Gemm g{(const bf16*)(ws + WS_WPB), (const bf16*)(ws + WS_XN), nullptr, nullptr, 1536, T, D}; pg8::StaticOrder S; S.init(1536, T, F.G, F.bid);
        pg8::EpiBf<0> E{(bf16*)(ws + WS_PBT), T};
        pg8::gemm_phase<pg8::EpiBf<0>, pg8::StaticOrder, true, true>(F.lds, g, S, E);
    }
    for (int it = gw; it < 32 * 128; it += NGW) filt_raw_item(args, it, F.lane, (const float*)(ws + WS_H2), args.out, (float*)(ws + WS_SSP));
    GRID_BAR();
    for (int u = F.bid; u < 256; u += F.G) spatial_unit(args, F, u);
    for (int c = F.bid; c < BW; c += F.G) conv_unit<0>(args, F, c);
    GRID_BAR();
    for (int c = F.bid; c < BW; c += F.G) conv_unit<1>(args, F, c);
    GRID_BAR();
    for (int it = gw; it < 8 * (T / 64); it += NGW) transpose_item(args, F, it);
    GRID_BAR();
    {
        pg8::Gemm g{(const bf16*)(ws + WS_YA), (const bf16*)(ws + WS_WA), (const bf16*)(ws + WS_YB), (const bf16*)(ws + WS_WB), T, D, 512}; pg8::ChainOrder S; S.init(T, D, F.G, F.bid);
        pg8::EpiMix E{(const bf16*)(ws + WS_GATES), (bf16*)(ws + WS_MIX)};
        pg8::gemm_phase<pg8::EpiMix, pg8::ChainOrder, false, true>(F.lds, g, S, E);
    }
    GRID_BAR();
    {
        pg8::Gemm g{(const bf16*)(ws + WS_MIX), (const bf16*)(ws + WS_WO), nullptr, nullptr, T, D, D}; pg8::StaticOrder S; S.init(T, D, F.G, F.bid);
        pg8::EpiF32 E{args.out, D};
        pg8::gemm_phase<pg8::EpiF32, pg8::StaticOrder, false, true>(F.lds, g, S, E);
    }
    GRID_BAR();
    for (int m = gw; m < T; m += NGW) post_mix_row(args, m, F.lane);
    GRID_BAR();
    {
        pg8::Gemm g{(const bf16*)(ws + WS_XN), (const bf16*)(ws + WS_W1), nullptr, nullptr, T, FF, D}; pg8::StaticOrder S; S.init(T, FF, F.G, F.bid);
        pg8::EpiBf<1> E{(bf16*)(ws + WS_F1), FF};
        pg8::gemm_phase<pg8::EpiBf<1>, pg8::StaticOrder, true, true>(F.lds, g, S, E);
    }
    GRID_BAR();
    {
        pg8::Gemm g{(const bf16*)(ws + WS_F1), (const bf16*)(ws + WS_W2), nullptr, nullptr, T, D, FF}; pg8::StaticOrder S; S.init(T, D, F.G, F.bid);
        pg8::EpiF32 E{(float*)(ws + WS_F), D};
        pg8::gemm_phase<pg8::EpiF32, pg8::StaticOrder, false, true>(F.lds, g, S, E);
    }
    GRID_BAR();
    for (int m = gw; m < T; m += NGW) post_ffn_row(args, m, F.lane);
}

extern "C" void kernel_launch(void* const* d_in, const int* in_sizes, int n_in, void* d_out, int out_size, void* d_ws, size_t ws_size, hipStream_t stream) {
    static int grid = 0;
    if (grid == 0) {
        if (n_in != 24 || in_sizes[0] != T * D || out_size != T * D || ws_size < WS_END) { fprintf(stderr, "kernel_launch: unexpected shapes (n_in %d, in0 %d, out %d, ws %zu); nothing launched\n", n_in, n_in > 0 ? in_sizes[0] : -1, out_size, ws_size); grid = -1; return; }
        int dev = 0, cus = 0, per_cu = 0;
        hipGetDevice(&dev); hipDeviceGetAttribute(&cus, hipDeviceAttributeMultiprocessorCount, dev);
        if (hipFuncSetAttribute((const void*)fwd_megakernel, hipFuncAttributeMaxDynamicSharedMemorySize, LDS_BYTES) != hipSuccess) { fprintf(stderr, "kernel_launch: hipFuncSetAttribute failed\n"); grid = -1; return; }
        hipOccupancyMaxActiveBlocksPerMultiprocessor(&per_cu, (const void*)fwd_megakernel, NTHR, LDS_BYTES);
        (void)hipGetLastError();
        if (per_cu < 1) { fprintf(stderr, "kernel_launch: occupancy query says %d blocks per CU\n", per_cu); per_cu = 1; }
        grid = cus;
    }
    if (grid < 0) return;
    if (hipMemsetAsync((char*)d_ws + WS_CTL, 0, 65536, stream) != hipSuccess) { fprintf(stderr, "kernel_launch: memset failed\n"); return; }
    Args a{};
    for (int i = 0; i < 24; ++i) a.in[i] = (const float*)d_in[i];
    a.out = (float*)d_out; a.ws = (unsigned char*)d_ws;
    void* kargs[] = {&a};
    hipError_t e = hipLaunchCooperativeKernel((const void*)fwd_megakernel, dim3(grid), dim3(NTHR), kargs, LDS_BYTES, stream);
    if (e != hipSuccess) fprintf(stderr, "cooperative launch failed: %s (grid %d)\n", hipGetErrorString(e), grid);
}
```
